# Optimizing an MI355X kernel written in HIP

```python
import jax, jax.numpy as jnp
from jax import lax
import numpy as np

D_MODEL = 1024
BATCH = 4
SEQ = 4096
DEPTH = 1

N_ATTN_HEADS = 8
HEAD_DIM = 64
ATTN_WIDTH = N_ATTN_HEADS * HEAD_DIM
POOL_WIDTH = D_MODEL - ATTN_WIDTH
POOL_WINDOWS = (2, 4, 8, 16)
N_POOL_GROUPS = len(POOL_WINDOWS)
POOL_GROUP = POOL_WIDTH // N_POOL_GROUPS
IN_WIDTH = 3 * ATTN_WIDTH + POOL_WIDTH
MOBA_BLOCK = 256
MOBA_TOPK = 3
QUERY_CHUNK = 32
D_FF = 4 * D_MODEL
EPS = 1e-6

kernel_name = "hymba_moba_pool_sqrelu_block"


def _alibi_slopes(n_heads):
    return jnp.asarray(2.0 ** (-8.0 * np.arange(1, n_heads + 1) / n_heads), dtype=jnp.float32)


def rms_norm(x, g):
    xf = x.astype(jnp.float32)
    y = xf * lax.rsqrt(jnp.mean(xf * xf, axis=-1, keepdims=True) + EPS)
    return (y * g.astype(jnp.float32)).astype(x.dtype)


def moba_attention(q, k, v):
    B, H, S, Dh = q.shape
    nb = -(-S // MOBA_BLOCK)
    pad = nb * MOBA_BLOCK - S
    kp = jnp.pad(k, ((0, 0), (0, 0), (0, pad), (0, 0)))
    vp = jnp.pad(v, ((0, 0), (0, 0), (0, pad), (0, 0)))
    kb = kp.reshape(B, H, nb, MOBA_BLOCK, Dh)
    vb = vp.reshape(B, H, nb, MOBA_BLOCK, Dh)
    slopes = _alibi_slopes(H)
    scale = HEAD_DIM ** -0.5

    counts = jnp.asarray(np.clip(S - np.arange(nb) * MOBA_BLOCK, 1, MOBA_BLOCK), dtype=jnp.float32)
    kmean = kb.astype(jnp.float32).sum(axis=3) / counts[:, None]
    pos = jnp.arange(S)
    qblk = pos // MOBA_BLOCK
    gate = jnp.einsum('bhtd,bhnd->bhtn', q.astype(jnp.float32), kmean)
    past = jnp.arange(nb)[None, :] < qblk[:, None]
    gate = jnp.where(past[None, None], gate, -jnp.inf)
    n_sel = max(1, min(MOBA_TOPK, nb - 1))
    _, sel = lax.top_k(gate, n_sel)
    sel_valid = jnp.arange(n_sel)[None, :] < qblk[:, None]

    nc = S // QUERY_CHUNK
    qc = q.reshape(B, H, nc, QUERY_CHUNK, Dh).transpose(2, 0, 1, 3, 4)
    selc = sel.reshape(B, H, nc, QUERY_CHUNK, n_sel).transpose(2, 0, 1, 3, 4)
    validc = sel_valid.reshape(nc, QUERY_CHUNK, n_sel)
    bi = jnp.arange(B)[:, None, None, None]
    hi = jnp.arange(H)[None, :, None, None]
    blk_off = jnp.arange(MOBA_BLOCK)

    def chunk(args):
        c, q_c, sel_c, valid_c = args
        t = c * QUERY_CHUNK + jnp.arange(QUERY_CHUNK)
        own = t[0] // MOBA_BLOCK
        k_own = lax.dynamic_index_in_dim(kb, own, axis=2, keepdims=False)
        v_own = lax.dynamic_index_in_dim(vb, own, axis=2, keepdims=False)
        s_own = own * MOBA_BLOCK + blk_off
        sc_own = jnp.einsum('bhtd,bhsd->bhts', q_c, k_own).astype(jnp.float32) * scale
        dist_own = (t[:, None] - s_own[None, :]).astype(jnp.float32)
        sc_own = sc_own - slopes[:, None, None] * dist_own[None]
        sc_own = jnp.where((s_own[None, :] <= t[:, None])[None, None], sc_own, -jnp.inf)

        k_sel = kb[bi, hi, sel_c]
        v_sel = vb[bi, hi, sel_c]
        s_sel = sel_c[..., None] * MOBA_BLOCK + blk_off
        sc_sel = jnp.einsum('bhtd,bhtrsd->bhtrs', q_c, k_sel).astype(jnp.float32) * scale
        dist_sel = (t[None, None, :, None, None] - s_sel).astype(jnp.float32)
        sc_sel = sc_sel - slopes[None, :, None, None, None] * dist_sel
        sc_sel = jnp.where(valid_c[None, None, :, :, None], sc_sel, -jnp.inf)

        scores = jnp.concatenate(
            [sc_own, sc_sel.reshape(B, H, QUERY_CHUNK, n_sel * MOBA_BLOCK)], axis=-1)
        p = jax.nn.softmax(scores, axis=-1)
        p_own = p[..., :MOBA_BLOCK].astype(v.dtype)
        p_sel = p[..., MOBA_BLOCK:].reshape(B, H, QUERY_CHUNK, n_sel, MOBA_BLOCK).astype(v.dtype)
        out = (jnp.einsum('bhts,bhsd->bhtd', p_own, v_own)
               + jnp.einsum('bhtrs,bhtrsd->bhtd', p_sel, v_sel))
        return out.astype(q.dtype)

    out = lax.map(chunk, (jnp.arange(nc), qc, selc, validc))
    return out.transpose(1, 2, 0, 3, 4).reshape(B, H, S, Dh)


def multiscale_pool(u, w_pool, pool_scale):
    B, S, _ = u.shape
    ug = u.astype(jnp.float32).reshape(B, S, N_POOL_GROUPS, POOL_GROUP)
    cs = jnp.cumsum(ug, axis=1)
    pos = jnp.arange(S)
    outs = []
    for g, w in enumerate(POOL_WINDOWS):
        c = cs[:, :, g]
        prev = jnp.pad(c, ((0, 0), (w, 0), (0, 0)))[:, :S]
        cnt = jnp.minimum(pos + 1, w).astype(jnp.float32)[None, :, None]
        outs.append((c - prev) / cnt - ug[:, :, g])
    mixed = jnp.stack(outs, axis=2)
    y = jnp.einsum('bsgc,gcd->bsgd', mixed, w_pool.astype(jnp.float32))
    y = y.reshape(B, S, POOL_WIDTH) * pool_scale.astype(jnp.float32)
    return y.astype(u.dtype)


def setup_inputs(seed: int = 0) -> dict:
    key = jax.random.key(seed)
    ks = jax.random.split(key, 12)
    f32 = jnp.float32
    x = jax.random.normal(ks[0], (BATCH, SEQ, D_MODEL), f32)
    norm_mix = 1.0 + 0.02 * jax.random.normal(ks[1], (DEPTH, D_MODEL), f32)
    w_in = jax.random.normal(ks[2], (DEPTH, D_MODEL, IN_WIDTH), f32) * D_MODEL ** -0.5
    w_pool = jax.random.normal(ks[3], (DEPTH, N_POOL_GROUPS, POOL_GROUP, POOL_GROUP), f32) * POOL_GROUP ** -0.5
    pool_scale = 1.0 + 0.02 * jax.random.normal(ks[4], (DEPTH, POOL_WIDTH), f32)
    w_out = jax.random.normal(ks[5], (DEPTH, D_MODEL, D_MODEL), f32) * D_MODEL ** -0.5
    norm_mlp = 1.0 + 0.02 * jax.random.normal(ks[6], (DEPTH, D_MODEL), f32)
    w_up = jax.random.normal(ks[7], (DEPTH, D_MODEL, D_FF), f32) * D_MODEL ** -0.5
    w_down = jax.random.normal(ks[8], (DEPTH, D_FF, D_MODEL), f32) * D_FF ** -0.5
    norm_final = 1.0 + 0.02 * jax.random.normal(ks[9], (D_MODEL,), f32)
    return {"x": x, "norm_mix": norm_mix, "w_in": w_in, "w_pool": w_pool,
            "pool_scale": pool_scale, "w_out": w_out, "norm_mlp": norm_mlp,
            "w_up": w_up, "w_down": w_down, "norm_final": norm_final}


def reference(x, norm_mix, w_in, w_pool, pool_scale, w_out, norm_mlp, w_up, w_down, norm_final):
    B, S, _ = x.shape
    for l in range(DEPTH):
        h = rms_norm(x, norm_mix[l])
        proj = h @ w_in[l]
        q, k, v, u = jnp.split(proj, [ATTN_WIDTH, 2 * ATTN_WIDTH, 3 * ATTN_WIDTH], axis=-1)
        to_heads = lambda t: t.reshape(B, S, N_ATTN_HEADS, HEAD_DIM).transpose(0, 2, 1, 3)
        a = moba_attention(to_heads(q), to_heads(k), to_heads(v))
        a = a.transpose(0, 2, 1, 3).reshape(B, S, ATTN_WIDTH)
        p = multiscale_pool(u, w_pool[l], pool_scale[l])
        x = x + jnp.concatenate([a, p], axis=-1) @ w_out[l]
        h = rms_norm(x, norm_mlp[l])
        x = x + jnp.square(jax.nn.relu(h @ w_up[l])) @ w_down[l]
    return rms_norm(x, norm_final)
```

```cpp
#include <hip/hip_runtime.h>
#include <cstdio>
#include <cstdint>

constexpr int BATCH = 4, SEQ = 4096, D = 1024, NH = 8, HD = 64, AW = 512, PW = 512, NG = 4, PG = 128, INW = 2048, FF = 4096;
constexpr int M = BATCH * SEQ;
constexpr int MB = 256, NBLK = SEQ / MB;
constexpr float EPS = 1e-6f;
constexpr float LOG2E = 1.4426950408889634f;
constexpr float C2 = 0.125f * LOG2E;

constexpr size_t MiB = 1u << 20;
constexpr size_t WS_CTL = 0, CTL_ZERO_BYTES = 1 * MiB;
constexpr size_t WS_WIN = 2 * MiB, WS_WOUT = 6 * MiB, WS_WUP = 8 * MiB, WS_WDN = 16 * MiB, WS_WP = 24 * MiB;
constexpr size_t WS_KM = 25 * MiB;
constexpr size_t WS_SSQ1 = 26 * MiB, WS_SSQ2 = 27 * MiB;
constexpr size_t WS_Q = 32 * MiB, WS_K = 48 * MiB, WS_V = 64 * MiB, WS_U = 80 * MiB;
constexpr size_t WS_AP = 96 * MiB;
constexpr size_t WS_H = 32 * MiB;
constexpr size_t WS_XN = 160 * MiB;
constexpr size_t WS_END = 192 * MiB;
constexpr int CW_TMO = 0, CW_CODE = 1;
constexpr int CW_BAR = 4096;
constexpr size_t CTL_SSQ1 = 256 * 1024, CTL_SSQ2 = 512 * 1024;

constexpr int NWAVES = 8;
constexpr int LDS_BYTES = 147456;

#define GAS __attribute__((address_space(1)))
#define LAS __attribute__((address_space(3)))
typedef unsigned short bf16;
typedef unsigned v4u __attribute__((ext_vector_type(4)));
typedef unsigned v2u __attribute__((ext_vector_type(2)));
typedef float f32x4 __attribute__((ext_vector_type(4)));

__device__ __forceinline__ unsigned f2bf(float f) { unsigned u = __builtin_bit_cast(unsigned, f); return (u + 0x7fffu + ((u >> 16) & 1u)) >> 16; }
__device__ __forceinline__ unsigned pk2(float lo, float hi) { return f2bf(lo) | (f2bf(hi) << 16); }
__device__ __forceinline__ float bf2f(unsigned b) { return __builtin_bit_cast(float, b << 16); }
__device__ __forceinline__ float wave_sum(float v) {
#pragma unroll
    for (int o = 1; o < 64; o <<= 1) v += __shfl_xor(v, o);
    return v;
}
__device__ __forceinline__ float wave_max(float v) {
#pragma unroll
    for (int o = 1; o < 64; o <<= 1) v = fmaxf(v, __shfl_xor(v, o));
    return v;
}

struct Frame {
    LAS unsigned char* lds;
    int tid, lane, wave, bid, G;
    const float *x, *norm_mix, *w_in, *w_pool, *pool_scale, *w_out, *norm_mlp, *w_up, *w_down, *norm_final;
    float* out;
    unsigned char* ws;
    bf16 *Q, *K, *V, *U, *AP, *H, *XN;
    float *KM, *SSQ1, *SSQ2;
};

template <class Epi>
__device__ __forceinline__ void golden_gemm(Frame& F, const bf16* A, const float* B, const float* kscale, int Mr, int N, int K, const Epi& E) {
    LAS float* As = (LAS float*)F.lds;
    LAS float* Bs = (LAS float*)(F.lds + 16 * 68 * 4);
    const int tid = F.tid, tx = tid & 31, ty = tid >> 5;
    const int tilesN = N / 128, ntiles = (Mr / 64) * tilesN;
    for (int t = F.bid; t < ntiles; t += F.G) {
        const int m0 = (t / tilesN) * 64, n0 = (t % tilesN) * 128;
        float acc[4][4];
#pragma unroll
        for (int i = 0; i < 4; ++i)
#pragma unroll
            for (int j = 0; j < 4; ++j) acc[i][j] = 0.f;
        for (int k0 = 0; k0 < K; k0 += 16) {
            { const int r = tid >> 3, kk = (tid & 7) * 2; const unsigned v = *(const unsigned*)(A + (size_t)(m0 + r) * K + k0 + kk);
              As[kk * 68 + r] = bf2f(v & 0xffffu); As[(kk + 1) * 68 + r] = bf2f(v >> 16); }
            { const int kk = tid >> 5, n = (tid & 31) * 4; f32x4 v = *(const f32x4*)(B + (size_t)(k0 + kk) * N + n0 + n); if (kscale) v = v * kscale[k0 + kk];
              *(LAS f32x4*)(Bs + kk * 132 + n) = v; }
            __syncthreads();
#pragma unroll
            for (int kk = 0; kk < 16; ++kk) {
                const f32x4 a = *(const LAS f32x4*)(As + kk * 68 + ty * 4), b = *(const LAS f32x4*)(Bs + kk * 132 + tx * 4);
#pragma unroll
                for (int i = 0; i < 4; ++i)
#pragma unroll
                    for (int j = 0; j < 4; ++j) acc[i][j] = fmaf(a[i], b[j], acc[i][j]);
            }
            __syncthreads();
        }
#pragma unroll
        for (int i = 0; i < 4; ++i) E(m0 + ty * 4 + i, n0 + tx * 4, (f32x4){acc[i][0], acc[i][1], acc[i][2], acc[i][3]});
    }
}

struct GEpiInproj {
    bf16 *Q, *K, *V, *U;
    __device__ __forceinline__ void operator()(int m, int n, f32x4 v) const {
        const int t = n >> 9, c = n & 511; bf16* base = t == 0 ? Q : t == 1 ? K : t == 2 ? V : U;
        if (t == 0) v = v * C2;
        v2u w; w.x = pk2(v[0], v[1]); w.y = pk2(v[2], v[3]); *(v2u*)(base + (size_t)m * 512 + c) = w;
    }
};
struct GEpiOut {
    const float* x; float* out; bf16* XN; float* SSQ;
    __device__ __forceinline__ void operator()(int m, int n, f32x4 v) const {
        const f32x4 b = *(const f32x4*)(x + (size_t)m * D + n); const f32x4 r = b + v; *(f32x4*)(out + (size_t)m * D + n) = r;
        v2u w; w.x = pk2(r[0], r[1]); w.y = pk2(r[2], r[3]); *(v2u*)(XN + (size_t)m * D + n) = w;
        atomicAdd(SSQ + (size_t)m * 4 + (n >> 8), r[0] * r[0] + r[1] * r[1] + r[2] * r[2] + r[3] * r[3]);
    }
};
struct GEpiUp {
    bf16* H; const float* SSQ;
    __device__ __forceinline__ void operator()(int m, int n, f32x4 v) const {
        const f32x4 s = *(const f32x4*)(SSQ + (size_t)m * 4); const float rstd = rsqrtf(((s[0] + s[1]) + (s[2] + s[3])) * (1.f / D) + EPS);
        const float a0 = fmaxf(v[0] * rstd, 0.f), a1 = fmaxf(v[1] * rstd, 0.f), a2 = fmaxf(v[2] * rstd, 0.f), a3 = fmaxf(v[3] * rstd, 0.f);
        const f32x4 r = (f32x4){a0 * a0, a1 * a1, a2 * a2, a3 * a3};
        v2u w; w.x = pk2(r[0], r[1]); w.y = pk2(r[2], r[3]); *(v2u*)(H + (size_t)m * FF + n) = w;
    }
};
struct GEpiDown {
    float* out; float* SSQ;
    __device__ __forceinline__ void operator()(int m, int n, f32x4 v) const {
        const f32x4 b = *(const f32x4*)(out + (size_t)m * D + n); const f32x4 r = b + v; *(f32x4*)(out + (size_t)m * D + n) = r;
        atomicAdd(SSQ + (size_t)m * 4 + (n >> 8), r[0] * r[0] + r[1] * r[1] + r[2] * r[2] + r[3] * r[3]);
    }
};

__device__ __forceinline__ void rms_rows_to_bf16(Frame& F, const float* x, const float* g, bf16* o) {
    const int gw = F.bid * NWAVES + F.wave, NGW = F.G * NWAVES;
    for (int m = gw; m < M; m += NGW) {
        const f32x4* xr = (const f32x4*)(x + (size_t)m * D) + F.lane; const f32x4* gr = (const f32x4*)g + F.lane;
        f32x4 v[4]; float s = 0.f;
#pragma unroll
        for (int j = 0; j < 4; ++j) { v[j] = xr[64 * j]; s += (v[j].x * v[j].x + v[j].y * v[j].y) + (v[j].z * v[j].z + v[j].w * v[j].w); }
        const float rstd = rsqrtf(wave_sum(s) * (1.f / D) + EPS);
        unsigned long long* o8 = (unsigned long long*)(o + (size_t)m * D) + F.lane;
#pragma unroll
        for (int j = 0; j < 4; ++j) { const f32x4 gg = gr[64 * j]; const f32x4 y = v[j] * rstd * gg;
            o8[64 * j] = (unsigned long long)pk2(y.x, y.y) | ((unsigned long long)pk2(y.z, y.w) << 32); }
    }
}
__device__ __forceinline__ void final_norm_rows(Frame& F, float* out, const float* SSQ, const float* g) {
    const int gw = F.bid * NWAVES + F.wave, NGW = F.G * NWAVES;
    for (int m = gw; m < M; m += NGW) {
        const f32x4 s = *(const f32x4*)(SSQ + (size_t)m * 4); const float rstd = rsqrtf(((s[0] + s[1]) + (s[2] + s[3])) * (1.f / D) + EPS);
        f32x4* xr = (f32x4*)(out + (size_t)m * D) + F.lane; const f32x4* gr = (const f32x4*)g + F.lane;
#pragma unroll
        for (int j = 0; j < 4; ++j) { const f32x4 v = xr[64 * j]; xr[64 * j] = v * rstd * gr[64 * j]; }
    }
}
__device__ __forceinline__ void golden_kmean(Frame& F) {
    const int gt = F.bid * (NWAVES * 64) + F.tid, NT = F.G * NWAVES * 64;
    for (int i = gt; i < 64 * 512; i += NT) { const int p = i >> 9, c = i & 511; float s = 0.f;
        for (int r = 0; r < 256; ++r) s += bf2f(F.K[(size_t)(p * 256 + r) * 512 + c]);
        F.KM[(size_t)p * 1024 + c] = s; F.KM[(size_t)p * 1024 + 512 + c] = 0.f; }
}

__device__ __forceinline__ void golden_attention(Frame& F) {
    LAS float* wq = (LAS float*)(F.lds) + F.wave * 1088;
    LAS float* wp = wq + 64;
    const int gw = F.bid * NWAVES + F.wave, NGW = F.G * NWAVES, lane = F.lane;
    for (int it = gw; it < M * NH; it += NGW) {
        const int m = it >> 3, h = it & 7, b = m / SEQ, t = m % SEQ, qb = t / MB;
        const float slope2 = exp2f(-(float)(h + 1)) * LOG2E;
        wq[lane] = bf2f(F.Q[(size_t)m * 512 + h * 64 + lane]);
        __builtin_amdgcn_s_waitcnt(0xC07F); __builtin_amdgcn_wave_barrier();
        float myg = -INFINITY;
        if (lane < 16 && lane < qb) { const float* k0 = F.KM + (size_t)(b * NBLK + lane) * 1024 + h * 64; float s = 0.f;
            for (int d = 0; d < 64; ++d) s = fmaf(wq[d], (k0[d] + k0[512 + d]) * (1.f / 256.f), s);
            myg = s; }
        float g[16];
#pragma unroll
        for (int n = 0; n < 16; ++n) g[n] = __shfl(myg, n);
        unsigned mask = 0u;
#pragma unroll
        for (int k = 0; k < 3; ++k) { if (k < qb) { float best = -INFINITY; int bi = 0; bool found = false;
#pragma unroll
                for (int n = 0; n < 16; ++n) { const bool ok = (n < qb) && !((mask >> n) & 1u) && (!found || g[n] > best); if (ok) { best = g[n]; bi = n; found = true; } }
                mask |= 1u << bi; } }
        mask |= 1u << qb;
        mask = (unsigned)__builtin_amdgcn_readfirstlane((int)mask);
        float mx = -INFINITY; int nblk = 0;
        for (unsigned mm = mask; mm; mm &= mm - 1u) { const int n = __builtin_ctz(mm);
            for (int j = 0; j < 4; ++j) { const int s = n * MB + j * 64 + lane; float sc = -INFINITY;
                if (s <= t) { const bf16* kr = F.K + (size_t)(b * SEQ + s) * 512 + h * 64; float a = 0.f;
                    for (int d = 0; d < 64; d += 2) { const unsigned kk = *(const unsigned*)(kr + d); a = fmaf(wq[d], bf2f(kk & 0xffffu), a); a = fmaf(wq[d + 1], bf2f(kk >> 16), a); }
                    sc = a - slope2 * (float)(t - s); }
                wp[nblk * 256 + j * 64 + lane] = sc; mx = fmaxf(mx, sc); }
            ++nblk; }
        mx = wave_max(mx);
        float l = 0.f;
        for (int i = lane; i < nblk * 256; i += 64) { const float p = exp2f(wp[i] - mx); wp[i] = p; l += p; }
        l = wave_sum(l);
        __builtin_amdgcn_s_waitcnt(0xC07F); __builtin_amdgcn_wave_barrier();
        float acc = 0.f; int bi = 0;
        for (unsigned mm = mask; mm; mm &= mm - 1u) { const int n = __builtin_ctz(mm); const bf16* vr = F.V + (size_t)(b * SEQ + n * MB) * 512 + h * 64 + lane;
            for (int j = 0; j < 256; ++j) acc = fmaf(wp[bi * 256 + j], bf2f(vr[(size_t)j * 512]), acc);
            ++bi; }
        F.AP[(size_t)m * D + h * 64 + lane] = (bf16)f2bf(acc / l);
        __builtin_amdgcn_s_waitcnt(0xC07F); __builtin_amdgcn_wave_barrier();
    }
}
__device__ __forceinline__ void golden_pool(Frame& F) {
    LAS float* mx = (LAS float*)(F.lds) + F.wave * 128;
    const int gw = F.bid * NWAVES + F.wave, NGW = F.G * NWAVES, lane = F.lane;
    for (int it = gw; it < M * NG; it += NGW) {
        const int m = it >> 2, g = it & 3, t = m % SEQ, w = 2 << g, cnt = (t + 1 < w) ? t + 1 : w;
#pragma unroll
        for (int cc = 0; cc < 2; ++cc) { const int c = lane + 64 * cc; float s = 0.f;
            for (int j = 0; j < cnt; ++j) s += bf2f(F.U[(size_t)(m - j) * 512 + g * 128 + c]);
            mx[c] = s / (float)cnt - bf2f(F.U[(size_t)m * 512 + g * 128 + c]); }
        __builtin_amdgcn_s_waitcnt(0xC07F); __builtin_amdgcn_wave_barrier();
#pragma unroll
        for (int cc = 0; cc < 2; ++cc) { const int d = lane + 64 * cc; float a = 0.f; const float* wpp = F.w_pool + (size_t)g * PG * PG + d;
            for (int c = 0; c < PG; ++c) a = fmaf(mx[c], wpp[(size_t)c * PG], a);
            F.AP[(size_t)m * D + 512 + g * 128 + d] = (bf16)f2bf(a * F.pool_scale[g * 128 + d]); }
        __builtin_amdgcn_s_waitcnt(0xC07F); __builtin_amdgcn_wave_barrier();
    }
}

constexpr int N_PHASES = 8;
struct Args { const float* in[10]; float* out; unsigned char* ws; int ph_lo, ph_hi, li, pad; };
__global__ void __launch_bounds__(NWAVES * 64, 2) skel_fwd(Args args) {
    extern __shared__ __attribute__((aligned(16))) unsigned char lds[];
    Frame F;
    F.lds = (LAS unsigned char*)lds;
    F.tid = threadIdx.x; F.lane = F.tid & 63; F.wave = __builtin_amdgcn_readfirstlane(F.tid >> 6); F.bid = blockIdx.x; F.G = gridDim.x;
    F.x = args.in[0]; F.norm_mix = args.in[1]; F.w_in = args.in[2]; F.w_pool = args.in[3]; F.pool_scale = args.in[4]; F.w_out = args.in[5];
    F.norm_mlp = args.in[6]; F.w_up = args.in[7]; F.w_down = args.in[8]; F.norm_final = args.in[9];
    F.out = args.out; F.ws = args.ws;
    unsigned char* ws = args.ws;
    F.Q = (bf16*)(ws + WS_Q); F.K = (bf16*)(ws + WS_K); F.V = (bf16*)(ws + WS_V); F.U = (bf16*)(ws + WS_U); F.AP = (bf16*)(ws + WS_AP); F.H = (bf16*)(ws + WS_H); F.XN = (bf16*)(ws + WS_XN);
    F.KM = (float*)(ws + WS_KM); F.SSQ1 = (float*)(ws + WS_CTL + CTL_SSQ1); F.SSQ2 = (float*)(ws + WS_CTL + CTL_SSQ2);
    const int lo = args.ph_lo, hi = args.ph_hi;
#define IN(k) (lo <= (k) && (k) < hi)
    if (IN(0)) { rms_rows_to_bf16(F, F.x, F.norm_mix, F.XN); }
    if (IN(1)) { GEpiInproj E{F.Q, F.K, F.V, F.U}; golden_gemm(F, F.XN, F.w_in, nullptr, M, INW, D, E); }
    if (IN(2)) { golden_kmean(F); }
    if (IN(3)) { golden_attention(F); __syncthreads(); golden_pool(F); }
    if (IN(4)) { GEpiOut E{F.x, F.out, F.XN, F.SSQ1}; golden_gemm(F, F.AP, F.w_out, nullptr, M, D, D, E); }
    if (IN(5)) { GEpiUp E{F.H, F.SSQ1}; golden_gemm(F, F.XN, F.w_up, F.norm_mlp, M, FF, D, E); }
    if (IN(6)) { GEpiDown E{F.out, F.SSQ2}; golden_gemm(F, F.H, F.w_down, nullptr, M, D, FF, E); }
    if (IN(7)) { final_norm_rows(F, F.out, F.SSQ2, F.norm_final); }
#undef IN
}

extern "C" void kernel_launch(void* const* d_in, const int* in_sizes, int n_in, void* d_out, int out_size, void* d_ws, size_t ws_size, hipStream_t stream) {
    static int grid = 0;
    if (grid == 0) {
        if (n_in != 10 || in_sizes[0] != M * D || out_size != M * D || ws_size < WS_END) { fprintf(stderr, "kernel_launch: unexpected shapes (n_in %d in0 %d out %d ws %zu)\n", n_in, n_in > 0 ? in_sizes[0] : -1, out_size, ws_size); grid = -1; return; }
        int dev = 0, cus = 0;
        if (hipGetDevice(&dev) != hipSuccess || hipDeviceGetAttribute(&cus, hipDeviceAttributeMultiprocessorCount, dev) != hipSuccess) { grid = -1; return; }
        if (hipFuncSetAttribute((const void*)skel_fwd, hipFuncAttributeMaxDynamicSharedMemorySize, LDS_BYTES) != hipSuccess) { fprintf(stderr, "kernel_launch: hipFuncSetAttribute failed\n"); grid = -1; return; }
        (void)hipGetLastError();
        grid = cus;
    }
    if (grid < 0) return;
    if (hipMemsetAsync((char*)d_ws + WS_CTL, 0, CTL_ZERO_BYTES, stream) != hipSuccess) return;
    Args a{};
    for (int i = 0; i < 10; ++i) a.in[i] = (const float*)d_in[i];
    a.out = (float*)d_out; a.ws = (unsigned char*)d_ws;
    for (int ph = 0; ph < N_PHASES; ++ph) {
        a.ph_lo = ph; a.ph_hi = ph + 1; a.li = ph;
        hipLaunchKernelGGL(skel_fwd, dim3(grid), dim3(NWAVES * 64), LDS_BYTES, stream, a);
    }
}
```

```cpp
#include <hip/hip_runtime.h>
#include <cstdio>
#include <cstdint>

#ifndef MK_N_LAUNCHES
#define MK_N_LAUNCHES 1
#endif
#ifndef G_P1
#define G_P1 0
#endif
#ifndef G_P3
#define G_P3 1
#endif
#ifndef G_P4
#define G_P4 0
#endif
#ifndef G_P5
#define G_P5 0
#endif
#ifndef G_P6
#define G_P6 0
#endif

constexpr int BATCH = 4, SEQ = 4096, D = 1024, NH = 8, HD = 64, AW = 512, PW = 512, NG = 4, PG = 128, INW = 2048, FF = 4096;
constexpr int M = BATCH * SEQ;
constexpr int MB = 256, NBLK = SEQ / MB;
constexpr float EPS = 1e-6f;
constexpr float LOG2E = 1.4426950408889634f;
constexpr float C2 = 0.125f * LOG2E;

constexpr size_t MiB = 1u << 20;
constexpr size_t WS_CTL = 0, CTL_ZERO_BYTES = 1 * MiB;
constexpr size_t WS_WIN = 2 * MiB, WS_WOUT = 6 * MiB, WS_WUP = 8 * MiB, WS_WDN = 16 * MiB, WS_WP = 24 * MiB;
constexpr size_t WS_KM = 25 * MiB;
constexpr size_t WS_SSQ1 = 26 * MiB, WS_SSQ2 = 27 * MiB;
constexpr size_t WS_Q = 32 * MiB, WS_K = 48 * MiB, WS_V = 64 * MiB, WS_U = 80 * MiB;
constexpr size_t WS_AP = 96 * MiB;
constexpr size_t WS_H = 32 * MiB;
constexpr size_t WS_XN = 160 * MiB;
constexpr size_t WS_END = 192 * MiB;
static_assert(WS_K - WS_Q == WS_V - WS_K && WS_V - WS_K == WS_U - WS_V, "Q|K|V|U equally spaced");
constexpr int CW_TMO = 0, CW_CODE = 1;
constexpr int CW_BAR = 4096;
constexpr size_t CTL_SSQ1 = 256 * 1024, CTL_SSQ2 = 512 * 1024;

constexpr int NWAVES = 8;
constexpr int RING_OFF = 0, RING_BYTES = 131072;
constexpr int LDSCTL_OFF = RING_BYTES, MISC_OFF = LDSCTL_OFF + 320;
constexpr int LDS_BYTES = 147456;
namespace pg8 {
#define PG8_LAS __attribute__((address_space(3)))
typedef unsigned short bf16_t;
typedef short bf16x8 __attribute__((ext_vector_type(8)));
typedef float f32x4 __attribute__((ext_vector_type(4)));
typedef unsigned u32x4 __attribute__((ext_vector_type(4)));
constexpr int BM = 256, BK = 64, HALF = 128, HTB = HALF * BK * 2  , STAGE_BYTES = 8 * HTB, NXCD = 8, WGM = 8;

__host__ __device__ __forceinline__ int lds_byte(int r, int c) { const int st = (r >> 4) * 2 + (c >> 5), rr = r & 15, cc = c & 31, ob = rr * 64 + cc * 2; return st * 1024 + (ob ^ (((ob >> 9) & 1) << 5)); }
__host__ __device__ __forceinline__ void stage_rc(int b, int& R, int& C) { const int st = b / 1024, sb = b % 1024, swz = sb ^ (((sb >> 9) & 1) << 5); R = (st >> 1) * 16 + swz / 64; C = (st & 1) * 32 + (swz % 64) / 2; }
__host__ __device__ __forceinline__ int perm32(int rho) { const int n = rho >> 4, i = rho & 15; return 8 * (i >> 2) + 4 * n + (i & 3); }

struct Unit { int pm, pn; };
struct Gemm { const bf16_t* A; const bf16_t* Bt; int M, N, K; };

struct StaticOrder {
    int nM, nN, nwg, G, c;
    __host__ __device__ void init(int M, int N, int G_, int c_) { nM = M / BM; nN = N / BM; nwg = nM * nN; G = G_; c = c_; }
    __host__ __device__ bool next(int i, Unit& u) const {
        const long L = (long)i * G + c; if (L >= nwg) return false;
        int wgid = (int)L; { const int q = nwg / NXCD, r = nwg % NXCD, xcd = wgid % NXCD, off = wgid / NXCD; wgid = (xcd < r ? xcd * (q + 1) : r * (q + 1) + (xcd - r) * q) + off; }
        const int nig = WGM * nN, gid = wgid / nig, fm = gid * WGM, gsz = (nM - fm) < WGM ? (nM - fm) : WGM;
        u.pm = fm + ((wgid % nig) % gsz); u.pn = (wgid % nig) / gsz; return true;
    }
    __device__ __forceinline__ void a_ready(const Unit&) const {}
    __device__ __forceinline__ void done(const Unit&) const {}
};


__device__ __forceinline__ unsigned cvt_pk_bf16(float lo, float hi) { unsigned r; asm volatile("v_cvt_pk_bf16_f32 %0, %1, %2" : "=v"(r) : "v"(lo), "v"(hi)); return r; }
typedef unsigned u32x2 __attribute__((ext_vector_type(2)));

struct EpiInproj {
    static constexpr bool PERM = true, AFTER_DRAIN = false;
    bf16_t* O; size_t split_stride; float scale0; float* KM;
    __device__ __forceinline__ void operator()(const f32x4 (&acc)[2][2][4][2], const Unit& u, int wr, int wc, int fr, int fq) const {
        const int row0 = u.pm * BM + wr * 64 + fr, t = u.pn >> 1, colt = (u.pn & 1) * BM;
        bf16_t* base = O + (size_t)t * split_stride; const float sc = (t == 0) ? scale0 : 1.f;
        const int col0 = colt + wc * 32 + 8 * fq;
#pragma unroll
        for (int ai = 0; ai < 2; ++ai)
#pragma unroll
            for (int m = 0; m < 4; ++m) { bf16_t* rowp = base + (size_t)(row0 + ai * HALF + m * 16) * 512 + col0;
#pragma unroll
                for (int bj = 0; bj < 2; ++bj) { const f32x4 v0 = acc[ai][bj][m][0] * sc, v1 = acc[ai][bj][m][1] * sc;
                    u32x4 w; w.x = cvt_pk_bf16(v0[0], v0[1]); w.y = cvt_pk_bf16(v0[2], v0[3]); w.z = cvt_pk_bf16(v1[0], v1[1]); w.w = cvt_pk_bf16(v1[2], v1[3]);
                    *(u32x4*)(rowp + bj * HALF) = w; } }
        if (t == 1) {
#pragma unroll
            for (int bj = 0; bj < 2; ++bj)
#pragma unroll
                for (int n = 0; n < 2; ++n) { f32x4 s = (f32x4){0.f, 0.f, 0.f, 0.f};
#pragma unroll
                    for (int ai = 0; ai < 2; ++ai)
#pragma unroll
                        for (int m = 0; m < 4; ++m) s += acc[ai][bj][m][n];
                    f32x4 r;
#pragma unroll
                    for (int j = 0; j < 4; ++j) { float x = s[j]; x += __shfl_xor(x, 1); x += __shfl_xor(x, 2); x += __shfl_xor(x, 4); x += __shfl_xor(x, 8); r[j] = x; }
                    if (fr == 0) *(f32x4*)(KM + (size_t)(u.pm * 2 + wr) * 512 + col0 + bj * HALF + 4 * n) = r; }
        }
    }
};
struct EpiUp {
    static constexpr bool PERM = true, AFTER_DRAIN = false;
    bf16_t* O; int ldc; const float* SSQ; float inv_n, eps;
    __device__ __forceinline__ void operator()(const f32x4 (&acc)[2][2][4][2], const Unit& u, int wr, int wc, int fr, int fq) const {
        const int row0 = u.pm * BM + wr * 64 + fr, col0 = u.pn * BM + wc * 32 + 8 * fq;
#pragma unroll
        for (int ai = 0; ai < 2; ++ai)
#pragma unroll
            for (int m = 0; m < 4; ++m) { const int row = row0 + ai * HALF + m * 16; const f32x4 s = *(const f32x4*)(SSQ + (size_t)row * 4);
                const float rstd = __builtin_amdgcn_rsqf(((s[0] + s[1]) + (s[2] + s[3])) * inv_n + eps); bf16_t* rowp = O + (size_t)row * ldc + col0;
#pragma unroll
                for (int bj = 0; bj < 2; ++bj) { f32x4 v0 = acc[ai][bj][m][0] * rstd, v1 = acc[ai][bj][m][1] * rstd;
#pragma unroll
                    for (int j = 0; j < 4; ++j) { const float a = __builtin_fmaxf(v0[j], 0.f), b = __builtin_fmaxf(v1[j], 0.f); v0[j] = a * a; v1[j] = b * b; }
                    u32x4 w; w.x = cvt_pk_bf16(v0[0], v0[1]); w.y = cvt_pk_bf16(v0[2], v0[3]); w.z = cvt_pk_bf16(v1[0], v1[1]); w.w = cvt_pk_bf16(v1[2], v1[3]);
                    *(u32x4*)(rowp + bj * HALF) = w; } }
    }
};
template <bool WB> struct EpiRes {
    static constexpr bool PERM = false, AFTER_DRAIN = true;
    const float* base; float* out; bf16_t* xb; float* SSQ; int ldc;
    __device__ __forceinline__ void fused(f32x4 (&acc)[2][2][4][2], const Unit& u, int wr, int wc, int fr, int fq, PG8_LAS unsigned char* lds, int wid, int lane) const {
        PG8_LAS float* P = (PG8_LAS float*)lds;
        const int col0 = u.pn * BM + wc * 32 + 4 * fq;
#pragma unroll
        for (int ai = 0; ai < 2; ++ai)
#pragma unroll
            for (int m = 0; m < 4; ++m) { const int r = ai * HALF + wr * 64 + m * 16 + fr; const size_t off = (size_t)(u.pm * BM + r) * ldc + col0; float q = 0.f;
#pragma unroll
                for (int bj = 0; bj < 2; ++bj)
#pragma unroll
                    for (int n = 0; n < 2; ++n) { const f32x4 bs = *(const f32x4*)(base + off + bj * HALF + n * 16); const f32x4 x = bs + acc[ai][bj][m][n];
                        *(f32x4*)(out + off + bj * HALF + n * 16) = x; q += (x[0] * x[0] + x[1] * x[1]) + (x[2] * x[2] + x[3] * x[3]);
                        if (WB) { u32x2 w; w.x = cvt_pk_bf16(x[0], x[1]); w.y = cvt_pk_bf16(x[2], x[3]); *(u32x2*)(xb + off + bj * HALF + n * 16) = w; } }
                q += __shfl_xor(q, 16); q += __shfl_xor(q, 32);
                if (fq == 0) P[r * 4 + wc] = q;
                if (m & 1) asm volatile("" ::: "memory"); }
        asm volatile("s_waitcnt lgkmcnt(0)" ::: "memory"); __builtin_amdgcn_s_barrier(); asm volatile("" ::: "memory");
        const int row = wid * 32 + (lane & 31);
        if (lane < 32) SSQ[(size_t)(u.pm * BM + row) * 4 + u.pn] = (P[row * 4 + 0] + P[row * 4 + 1]) + (P[row * 4 + 2] + P[row * 4 + 3]);
    }
};
template <class Epi, class Sched, bool ALIGN_EPI = false, bool SP2 = false>
__device__ __forceinline__ void gemm_phase(PG8_LAS unsigned char* lds, const Gemm g, const Sched& S, const Epi& E) {
    const int tid = threadIdx.x, wid = __builtin_amdgcn_readfirstlane(tid >> 6), lane = tid & 63, wr = wid >> 2, wc = wid & 3, fr = lane & 15, fq = lane >> 4;
    const int K = g.K, nt = K / BK;
    unsigned voffA[2], voffB[2];
#pragma unroll
    for (int i = 0; i < 2; ++i) { int R, C; stage_rc(tid * 16 + i * 8192, R, C); const int Rb = Epi::PERM ? ((R & ~31) + perm32(R & 31)) : R;
        voffA[i] = (unsigned)(R * K + C) * 2u; voffB[i] = (unsigned)(Rb * K + C) * 2u; }
    const size_t kstep = (size_t)(BK * 2);
    const size_t hstep = (size_t)HALF * K * 2;
    const size_t tstep = 2 * hstep;
    const unsigned ldsw = (unsigned)wid * 1024u;
    const int aoff = lds_byte(wr * 64 + fr, fq * 8), boff = lds_byte(wc * 32 + fr, fq * 8);
#define PG8_SA(b, h) (((b) * 2 + (h)) * HTB)
#define PG8_SB(b, h) ((4 + (b) * 2 + (h)) * HTB)
#define PG8_STAGE(bufoff, gbase, voff) do { _Pragma("unroll") for (int _i = 0; _i < 2; ++_i) \
        __builtin_amdgcn_global_load_lds((const unsigned*)((const char*)(gbase) + (voff)[_i]), (PG8_LAS unsigned*)(lds + (bufoff) + ldsw + _i * 8192), 16, 0, 0); } while (0)
#define PG8_LDA(dst, b, h) do { _Pragma("unroll") for (int m = 0; m < 4; ++m) _Pragma("unroll") for (int k = 0; k < 2; ++k) dst[m][k] = *(const PG8_LAS bf16x8*)(lds + PG8_SA(b, h) + aoff + m * 2048 + k * 1024); } while (0)
#define PG8_LDB(dst, b, h) do { _Pragma("unroll") for (int n = 0; n < 2; ++n) _Pragma("unroll") for (int k = 0; k < 2; ++k) dst[n][k] = *(const PG8_LAS bf16x8*)(lds + PG8_SB(b, h) + boff + n * 2048 + k * 1024); } while (0)
#define PG8_MMA(ai, bj, At, Bt) do { __builtin_amdgcn_s_setprio(1); _Pragma("unroll") for (int m = 0; m < 4; ++m) _Pragma("unroll") for (int n = 0; n < 2; ++n) _Pragma("unroll") for (int k = 0; k < 2; ++k) \
        acc[ai][bj][m][n] = __builtin_amdgcn_mfma_f32_16x16x32_bf16(Bt[n][k], At[m][k], acc[ai][bj][m][n], 0, 0, 0); __builtin_amdgcn_s_setprio(0); } while (0)
#define PG8_WAIT_V(n) asm volatile("s_waitcnt vmcnt(" #n ")" ::: "memory")
#define PG8_WAIT_L(n) asm volatile("s_waitcnt lgkmcnt(" #n ")" ::: "memory")
#define PG8_BAR __builtin_amdgcn_s_barrier()
#define PG8_SCHED __builtin_amdgcn_sched_barrier(0)
    Unit cur, nxt; int ui = 0;
    if (!S.next(0, cur)) return;
    f32x4 acc[2][2][4][2];
#pragma unroll
    for (int a = 0; a < 2; ++a)
#pragma unroll
        for (int b = 0; b < 2; ++b)
#pragma unroll
            for (int m = 0; m < 4; ++m)
#pragma unroll
                for (int n = 0; n < 2; ++n) acc[a][b][m][n] = (f32x4){0.f, 0.f, 0.f, 0.f};
    bf16x8 At[4][2], B0[2][2], B1[2][2];
    const char* cA = (const char*)g.A + (size_t)cur.pm * tstep; const char* cB = (const char*)g.Bt + (size_t)cur.pn * tstep;
    S.a_ready(cur);
    if constexpr (SP2) {
        PG8_STAGE(PG8_SB(0, 0), cB, voffB); PG8_STAGE(PG8_SB(0, 1), cB + hstep, voffB); PG8_STAGE(PG8_SA(0, 0), cA, voffA); PG8_STAGE(PG8_SA(0, 1), cA + hstep, voffA);
        if (wr == 1) PG8_BAR;
        PG8_WAIT_V(2); PG8_BAR;
        PG8_STAGE(PG8_SB(1, 0), cB + kstep, voffB); PG8_STAGE(PG8_SA(1, 0), cA + kstep, voffA); PG8_STAGE(PG8_SB(1, 1), cB + hstep + kstep, voffB);
        PG8_WAIT_V(6); PG8_BAR;
    } else {
        PG8_STAGE(PG8_SB(0, 0), cB, voffB); PG8_STAGE(PG8_SA(0, 0), cA, voffA); PG8_STAGE(PG8_SB(0, 1), cB + hstep, voffB); PG8_STAGE(PG8_SA(0, 1), cA + hstep, voffA);
        if (wr == 1) PG8_BAR;
        PG8_WAIT_V(4); PG8_BAR;
        PG8_STAGE(PG8_SB(1, 0), cB + kstep, voffB); PG8_STAGE(PG8_SA(1, 0), cA + kstep, voffA); PG8_STAGE(PG8_SB(1, 1), cB + hstep + kstep, voffB);
        PG8_WAIT_V(6); PG8_BAR;
    }
    for (;;) {
        const bool has_next = S.next(ui + 1, nxt);
        const char* nA = has_next ? (const char*)g.A + (size_t)nxt.pm * tstep : cA; const char* nB = has_next ? (const char*)g.Bt + (size_t)nxt.pn * tstep : cB;
        for (int t = 0; t < nt; t += 2) {
            const bool last = (t == nt - 2);
            const char* a1 = cA + (size_t)(t + 1) * kstep;
            const char* a2 = last ? nA : cA + (size_t)(t + 2) * kstep; const char* b2 = last ? nB : cB + (size_t)(t + 2) * kstep;
            const char* a3 = a2 + kstep; const char* b3 = b2 + kstep;
            if (last && has_next) S.a_ready(nxt);
            if constexpr (SP2) {
            PG8_LDB(B0, 0, 0); PG8_LDB(B1, 0, 1); PG8_SCHED; PG8_LDA(At, 0, 0); PG8_STAGE(PG8_SA(1, 1), a1 + hstep, voffA);
            PG8_WAIT_V(8); PG8_WAIT_L(0); PG8_BAR; PG8_MMA(0, 0, At, B0); PG8_MMA(0, 1, At, B1); PG8_BAR; PG8_SCHED;
            PG8_LDA(At, 0, 1); PG8_STAGE(PG8_SB(0, 0), b2, voffB); PG8_STAGE(PG8_SB(0, 1), b2 + hstep, voffB); PG8_STAGE(PG8_SA(0, 0), a2, voffA);
            PG8_WAIT_V(8); PG8_WAIT_L(0); PG8_BAR; PG8_MMA(1, 0, At, B0); PG8_MMA(1, 1, At, B1); PG8_BAR; PG8_SCHED;
            PG8_LDB(B0, 1, 0); PG8_LDB(B1, 1, 1); PG8_SCHED; PG8_LDA(At, 1, 0); PG8_STAGE(PG8_SA(0, 1), a2 + hstep, voffA);
            PG8_WAIT_V(8); PG8_WAIT_L(0); PG8_BAR; PG8_MMA(0, 0, At, B0); PG8_MMA(0, 1, At, B1); PG8_BAR; PG8_SCHED;
            PG8_LDA(At, 1, 1); PG8_STAGE(PG8_SB(1, 0), b3, voffB); PG8_STAGE(PG8_SB(1, 1), b3 + hstep, voffB); PG8_STAGE(PG8_SA(1, 0), a3, voffA);
            PG8_WAIT_V(8); PG8_WAIT_L(0); PG8_BAR; PG8_MMA(1, 0, At, B0); PG8_MMA(1, 1, At, B1); PG8_BAR; PG8_SCHED;
            } else {
            PG8_LDB(B0, 0, 0); PG8_SCHED; PG8_LDA(At, 0, 0); PG8_STAGE(PG8_SA(1, 1), a1 + hstep, voffA);
            PG8_WAIT_L(8); PG8_BAR; PG8_WAIT_L(0); PG8_MMA(0, 0, At, B0); PG8_BAR; PG8_SCHED;
            PG8_LDB(B1, 0, 1); PG8_STAGE(PG8_SB(0, 0), b2, voffB);
            PG8_BAR; PG8_WAIT_L(0); PG8_MMA(0, 1, At, B1); PG8_BAR;
            PG8_LDA(At, 0, 1); PG8_STAGE(PG8_SA(0, 0), a2, voffA);
            PG8_BAR; PG8_WAIT_L(0); PG8_MMA(1, 0, At, B0); PG8_BAR; PG8_SCHED;
            PG8_STAGE(PG8_SB(0, 1), b2 + hstep, voffB);
            PG8_WAIT_V(6); PG8_BAR; PG8_MMA(1, 1, At, B1); PG8_BAR;
            PG8_LDB(B0, 1, 0); PG8_SCHED; PG8_LDA(At, 1, 0); PG8_STAGE(PG8_SA(0, 1), a2 + hstep, voffA);
            PG8_WAIT_L(8); PG8_BAR; PG8_WAIT_L(0); PG8_MMA(0, 0, At, B0); PG8_BAR; PG8_SCHED;
            PG8_LDB(B1, 1, 1); PG8_STAGE(PG8_SB(1, 0), b3, voffB);
            PG8_BAR; PG8_WAIT_L(0); PG8_MMA(0, 1, At, B1); PG8_BAR;
            PG8_LDA(At, 1, 1); PG8_STAGE(PG8_SA(1, 0), a3, voffA);
            PG8_BAR; PG8_WAIT_L(0); PG8_MMA(1, 0, At, B0); PG8_BAR; PG8_SCHED;
            PG8_STAGE(PG8_SB(1, 1), b3 + hstep, voffB);
            PG8_WAIT_V(6); PG8_BAR; PG8_MMA(1, 1, At, B1); PG8_BAR;
            }
        }
        if constexpr (ALIGN_EPI) { if (wr == 0) PG8_BAR; }
        if constexpr (!Epi::AFTER_DRAIN) { E(acc, cur, wr, wc, fr, fq); S.done(cur); }
        if (!has_next) break;
#pragma unroll
        for (int a = 0; a < 2; ++a)
#pragma unroll
            for (int b = 0; b < 2; ++b)
#pragma unroll
                for (int m = 0; m < 4; ++m)
#pragma unroll
                    for (int n = 0; n < 2; ++n) acc[a][b][m][n] = (f32x4){0.f, 0.f, 0.f, 0.f};
        cur = nxt; cA = nA; cB = nB; ++ui;
        if constexpr (ALIGN_EPI) { if (wr == 1) PG8_BAR; }
    }
    PG8_WAIT_V(0);
    if constexpr (!ALIGN_EPI) { if (wr == 0) PG8_BAR; }
    PG8_BAR;
    if constexpr (Epi::AFTER_DRAIN) { E.fused(acc, cur, wr, wc, fr, fq, lds, wid, lane); S.done(cur); }
#undef PG8_SA
#undef PG8_SB
#undef PG8_STAGE
#undef PG8_LDA
#undef PG8_LDB
#undef PG8_MMA
#undef PG8_WAIT_V
#undef PG8_WAIT_L
#undef PG8_BAR
#undef PG8_SCHED
}
}
#define GAS __attribute__((address_space(1)))
#define LAS __attribute__((address_space(3)))
typedef unsigned short bf16;
typedef unsigned v4u __attribute__((ext_vector_type(4)));
typedef unsigned v2u __attribute__((ext_vector_type(2)));
typedef float f32x4 __attribute__((ext_vector_type(4)));
typedef GAS unsigned gu32;
#define RLX_AGENT __ATOMIC_RELAXED, __HIP_MEMORY_SCOPE_AGENT
#define LDS_WAIT() asm volatile("s_waitcnt lgkmcnt(0)" ::: "memory")
#define VM_WAIT() asm volatile("s_waitcnt vmcnt(0)" ::: "memory")
__device__ __forceinline__ unsigned f2bf(float f) { unsigned u = __builtin_bit_cast(unsigned, f); return (u + 0x7fffu + ((u >> 16) & 1u)) >> 16; }
__device__ __forceinline__ unsigned pk2(float lo, float hi) { return f2bf(lo) | (f2bf(hi) << 16); }
__device__ __forceinline__ float bf2f(unsigned b) { return __builtin_bit_cast(float, b << 16); }
__device__ __forceinline__ float wave_sum(float v) {
#pragma unroll
    for (int o = 1; o < 64; o <<= 1) v += __shfl_xor(v, o);
    return v;
}
__device__ __forceinline__ float wave_max(float v) {
#pragma unroll
    for (int o = 1; o < 64; o <<= 1) v = fmaxf(v, __shfl_xor(v, o));
    return v;
}
#define XB_TMO      128
#define XB_XCNT(j)  (256  + 64 * (j))
#define XB_XSUB(j)  (1280 + 64 * (j))
#define XB_XGEN(j)  (2304 + 64 * (j))
#define XB_TOP      3328
#define XB_TOPGEN   3392
#define XCD_BAR_WORDS 3456
#define XB_SPIN_CAP (1u << 18)

__device__ __forceinline__ unsigned xb_ld(unsigned* p)              { return __hip_atomic_load(p, __ATOMIC_RELAXED, __HIP_MEMORY_SCOPE_AGENT); }
__device__ __forceinline__ unsigned xb_add(unsigned* p, unsigned v) { return __hip_atomic_fetch_add(p, v, __ATOMIC_RELAXED, __HIP_MEMORY_SCOPE_AGENT); }
__device__ __forceinline__ unsigned xb_xcc_id() { return (unsigned)__builtin_amdgcn_s_getreg((3 << 11) | 20) & 0xFu; }
#define XB_SPIN(cond, bar) do { unsigned _sp = 0; while (cond) { __builtin_amdgcn_s_sleep(1); \
    if ((++_sp & 255u) == 0u) { if (xb_ld(&(bar)[XB_TMO])) break; if (_sp > XB_SPIN_CAP) { atomicAdd(&(bar)[XB_TMO], 1u); break; } } } } while (0)

struct XcdBarrier {
    unsigned* bar; unsigned x;
    volatile LAS unsigned* st;
};

__device__ __forceinline__ XcdBarrier xcd_barrier_post(unsigned* bar, volatile LAS unsigned* st) {
    XcdBarrier b; b.bar = bar; b.x = xb_xcc_id(); b.st = st;
    if (threadIdx.x == 0) (void)xb_add(&bar[XB_XCNT(b.x)], 1u);
    return b;
}
__device__ __forceinline__ void xcd_barrier_complete(unsigned* bar, unsigned x, unsigned& nloc, unsigned& nx) {
    const unsigned G = gridDim.x * gridDim.y * gridDim.z;
    unsigned sum, cnt, mine, sp = 0u;
    for (;;) {
        sum = 0u; cnt = 0u; mine = 0u;
#pragma unroll
        for (unsigned j = 0; j < 16; ++j) { const unsigned c = xb_ld(&bar[XB_XCNT(j)]); sum += c; cnt += (c > 0u) ? 1u : 0u; mine = (j == x) ? c : mine; }
        if (sum == G) break;
        __builtin_amdgcn_s_sleep(1);
        if ((++sp & 255u) == 0u) { if (xb_ld(&bar[XB_TMO])) break; if (sp > XB_SPIN_CAP) { atomicAdd(&bar[XB_TMO], 1u); break; } }
    }
    nloc = mine > 0u ? mine : 1u; nx = cnt > 0u ? cnt : 1u;
}

__device__ __forceinline__ void xcd_barrier(const XcdBarrier& b) {
    asm volatile("s_waitcnt vmcnt(0)" ::: "memory");
    __syncthreads();
    if (threadIdx.x == 0) {
        unsigned* bar = b.bar;
        __builtin_amdgcn_s_waitcnt(0);
        unsigned nloc = b.st[0], nx = b.st[1];
        if (nloc == 0u) { xcd_barrier_complete(bar, b.x, nloc, nx); b.st[0] = nloc; b.st[1] = nx; }
        const unsigned old = xb_add(&bar[XB_XSUB(b.x)], 1u);
        const unsigned gen = old / nloc;
        if (old + 1u == (gen + 1u) * nloc) {
            __builtin_amdgcn_fence(__ATOMIC_RELEASE, "agent");
            asm volatile("s_waitcnt vmcnt(0)" ::: "memory");
            const unsigned og = xb_add(&bar[XB_TOP], 1u);
            const unsigned tg = og / nx;
            if (og + 1u == (tg + 1u) * nx) xb_add(&bar[XB_TOPGEN], 1u);
            else XB_SPIN(xb_ld(&bar[XB_TOPGEN]) == tg, bar);
            __builtin_amdgcn_fence(__ATOMIC_ACQUIRE, "agent");
            xb_add(&bar[XB_XGEN(b.x)], 1u);
            asm volatile("s_waitcnt vmcnt(0)" ::: "memory");
        } else {
            XB_SPIN(xb_ld(&bar[XB_XGEN(b.x)]) == gen, bar);
            __builtin_amdgcn_fence(__ATOMIC_ACQUIRE, "agent");
            asm volatile("s_waitcnt vmcnt(0)" ::: "memory");
        }
    }
    __syncthreads();
}
struct Frame {
    LAS unsigned char* lds;
    volatile LAS unsigned* MISC;
    gu32* ctl;
    int tid, lane, wave, bid, G, vcu;
    const float *x, *norm_mix, *w_in, *w_pool, *pool_scale, *w_out, *norm_mlp, *w_up, *w_down, *norm_final;
    float* out;
    unsigned char* ws;
    bf16 *WinT, *WoutT, *WupT, *WdnT, *WpT;
    bf16 *Q, *K, *V, *U, *AP, *H, *XN;
    float *KM, *SSQ1, *SSQ2;
};
template <class Epi>
__device__ __forceinline__ void golden_gemm(Frame& F, const bf16* A, const float* B, const float* kscale, int Mr, int N, int K, const Epi& E) {
    LAS float* As = (LAS float*)F.lds;
    LAS float* Bs = (LAS float*)(F.lds + 16 * 68 * 4);
    const int tid = F.tid, tx = tid & 31, ty = tid >> 5;
    const int tilesN = N / 128, ntiles = (Mr / 64) * tilesN;
    for (int t = F.bid; t < ntiles; t += F.G) {
        const int m0 = (t / tilesN) * 64, n0 = (t % tilesN) * 128;
        float acc[4][4];
#pragma unroll
        for (int i = 0; i < 4; ++i)
#pragma unroll
            for (int j = 0; j < 4; ++j) acc[i][j] = 0.f;
        for (int k0 = 0; k0 < K; k0 += 16) {
            { const int r = tid >> 3, kk = (tid & 7) * 2; const unsigned v = *(const unsigned*)(A + (size_t)(m0 + r) * K + k0 + kk);
              As[kk * 68 + r] = bf2f(v & 0xffffu); As[(kk + 1) * 68 + r] = bf2f(v >> 16); }
            { const int kk = tid >> 5, n = (tid & 31) * 4; f32x4 v = *(const f32x4*)(B + (size_t)(k0 + kk) * N + n0 + n); if (kscale) v = v * kscale[k0 + kk];
              *(LAS f32x4*)(Bs + kk * 132 + n) = v; }
            __syncthreads();
#pragma unroll
            for (int kk = 0; kk < 16; ++kk) {
                const f32x4 a = *(const LAS f32x4*)(As + kk * 68 + ty * 4), b = *(const LAS f32x4*)(Bs + kk * 132 + tx * 4);
#pragma unroll
                for (int i = 0; i < 4; ++i)
#pragma unroll
                    for (int j = 0; j < 4; ++j) acc[i][j] = fmaf(a[i], b[j], acc[i][j]);
            }
            __syncthreads();
        }
#pragma unroll
        for (int i = 0; i < 4; ++i) E(m0 + ty * 4 + i, n0 + tx * 4, (f32x4){acc[i][0], acc[i][1], acc[i][2], acc[i][3]});
    }
}

struct GEpiInproj {
    bf16 *Q, *K, *V, *U;
    __device__ __forceinline__ void operator()(int m, int n, f32x4 v) const {
        const int t = n >> 9, c = n & 511; bf16* base = t == 0 ? Q : t == 1 ? K : t == 2 ? V : U;
        if (t == 0) v = v * C2;
        v2u w; w.x = pk2(v[0], v[1]); w.y = pk2(v[2], v[3]); *(v2u*)(base + (size_t)m * 512 + c) = w;
    }
};
struct GEpiOut {
    const float* x; float* out; bf16* XN; float* SSQ;
    __device__ __forceinline__ void operator()(int m, int n, f32x4 v) const {
        const f32x4 b = *(const f32x4*)(x + (size_t)m * D + n); const f32x4 r = b + v; *(f32x4*)(out + (size_t)m * D + n) = r;
        v2u w; w.x = pk2(r[0], r[1]); w.y = pk2(r[2], r[3]); *(v2u*)(XN + (size_t)m * D + n) = w;
        atomicAdd(SSQ + (size_t)m * 4 + (n >> 8), r[0] * r[0] + r[1] * r[1] + r[2] * r[2] + r[3] * r[3]);
    }
};
struct GEpiUp {
    bf16* H; const float* SSQ;
    __device__ __forceinline__ void operator()(int m, int n, f32x4 v) const {
        const f32x4 s = *(const f32x4*)(SSQ + (size_t)m * 4); const float rstd = rsqrtf(((s[0] + s[1]) + (s[2] + s[3])) * (1.f / D) + EPS);
        const float a0 = fmaxf(v[0] * rstd, 0.f), a1 = fmaxf(v[1] * rstd, 0.f), a2 = fmaxf(v[2] * rstd, 0.f), a3 = fmaxf(v[3] * rstd, 0.f);
        const f32x4 r = (f32x4){a0 * a0, a1 * a1, a2 * a2, a3 * a3};
        v2u w; w.x = pk2(r[0], r[1]); w.y = pk2(r[2], r[3]); *(v2u*)(H + (size_t)m * FF + n) = w;
    }
};
struct GEpiDown {
    float* out; float* SSQ;
    __device__ __forceinline__ void operator()(int m, int n, f32x4 v) const {
        const f32x4 b = *(const f32x4*)(out + (size_t)m * D + n); const f32x4 r = b + v; *(f32x4*)(out + (size_t)m * D + n) = r;
        atomicAdd(SSQ + (size_t)m * 4 + (n >> 8), r[0] * r[0] + r[1] * r[1] + r[2] * r[2] + r[3] * r[3]);
    }
};

__device__ __forceinline__ void rms_rows_to_bf16(Frame& F, const float* x, const float* g, bf16* o) {
    const int gw = F.bid * NWAVES + F.wave, NGW = F.G * NWAVES;
    for (int m = gw; m < M; m += NGW) {
        const f32x4* xr = (const f32x4*)(x + (size_t)m * D) + F.lane; const f32x4* gr = (const f32x4*)g + F.lane;
        f32x4 v[4]; float s = 0.f;
#pragma unroll
        for (int j = 0; j < 4; ++j) { v[j] = xr[64 * j]; s += (v[j].x * v[j].x + v[j].y * v[j].y) + (v[j].z * v[j].z + v[j].w * v[j].w); }
        const float rstd = rsqrtf(wave_sum(s) * (1.f / D) + EPS);
        unsigned long long* o8 = (unsigned long long*)(o + (size_t)m * D) + F.lane;
#pragma unroll
        for (int j = 0; j < 4; ++j) { const f32x4 gg = gr[64 * j]; const f32x4 y = v[j] * rstd * gg;
            o8[64 * j] = (unsigned long long)pk2(y.x, y.y) | ((unsigned long long)pk2(y.z, y.w) << 32); }
    }
}
__device__ __forceinline__ void final_norm_rows(Frame& F, float* out, const float* SSQ, const float* g) {
    const int gw = F.bid * NWAVES + F.wave, NGW = F.G * NWAVES;
    for (int m = gw; m < M; m += NGW) {
        const f32x4 s = *(const f32x4*)(SSQ + (size_t)m * 4); const float rstd = rsqrtf(((s[0] + s[1]) + (s[2] + s[3])) * (1.f / D) + EPS);
        f32x4* xr = (f32x4*)(out + (size_t)m * D) + F.lane; const f32x4* gr = (const f32x4*)g + F.lane;
#pragma unroll
        for (int j = 0; j < 4; ++j) { const f32x4 v = xr[64 * j]; xr[64 * j] = v * rstd * gr[64 * j]; }
    }
}
__device__ __forceinline__ void golden_kmean(Frame& F) {
    const int gt = F.bid * (NWAVES * 64) + F.tid, NT = F.G * NWAVES * 64;
    for (int i = gt; i < 64 * 512; i += NT) { const int p = i >> 9, c = i & 511; float s = 0.f;
        for (int r = 0; r < 256; ++r) s += bf2f(F.K[(size_t)(p * 256 + r) * 512 + c]);
        F.KM[(size_t)p * 1024 + c] = s; F.KM[(size_t)p * 1024 + 512 + c] = 0.f; }
}

__device__ __forceinline__ void golden_attention(Frame& F) {
    LAS float* wq = (LAS float*)(F.lds) + F.wave * 1088;
    LAS float* wp = wq + 64;
    const int gw = F.bid * NWAVES + F.wave, NGW = F.G * NWAVES, lane = F.lane;
    for (int it = gw; it < M * NH; it += NGW) {
        const int m = it >> 3, h = it & 7, b = m / SEQ, t = m % SEQ, qb = t / MB;
        const float slope2 = exp2f(-(float)(h + 1)) * LOG2E;
        wq[lane] = bf2f(F.Q[(size_t)m * 512 + h * 64 + lane]);
        __builtin_amdgcn_s_waitcnt(0xC07F); __builtin_amdgcn_wave_barrier();
        float myg = -INFINITY;
        if (lane < 16 && lane < qb) { const float* k0 = F.KM + (size_t)(b * NBLK + lane) * 1024 + h * 64; float s = 0.f;
            for (int d = 0; d < 64; ++d) s = fmaf(wq[d], (k0[d] + k0[512 + d]) * (1.f / 256.f), s);
            myg = s; }
        float g[16];
#pragma unroll
        for (int n = 0; n < 16; ++n) g[n] = __shfl(myg, n);
        unsigned mask = 0u;
#pragma unroll
        for (int k = 0; k < 3; ++k) { if (k < qb) { float best = -INFINITY; int bi = 0; bool found = false;
#pragma unroll
                for (int n = 0; n < 16; ++n) { const bool ok = (n < qb) && !((mask >> n) & 1u) && (!found || g[n] > best); if (ok) { best = g[n]; bi = n; found = true; } }
                mask |= 1u << bi; } }
        mask |= 1u << qb;
        mask = (unsigned)__builtin_amdgcn_readfirstlane((int)mask);
        float mx = -INFINITY; int nblk = 0;
        for (unsigned mm = mask; mm; mm &= mm - 1u) { const int n = __builtin_ctz(mm);
            for (int j = 0; j < 4; ++j) { const int s = n * MB + j * 64 + lane; float sc = -INFINITY;
                if (s <= t) { const bf16* kr = F.K + (size_t)(b * SEQ + s) * 512 + h * 64; float a = 0.f;
                    for (int d = 0; d < 64; d += 2) { const unsigned kk = *(const unsigned*)(kr + d); a = fmaf(wq[d], bf2f(kk & 0xffffu), a); a = fmaf(wq[d + 1], bf2f(kk >> 16), a); }
                    sc = a - slope2 * (float)(t - s); }
                wp[nblk * 256 + j * 64 + lane] = sc; mx = fmaxf(mx, sc); }
            ++nblk; }
        mx = wave_max(mx);
        float l = 0.f;
        for (int i = lane; i < nblk * 256; i += 64) { const float p = exp2f(wp[i] - mx); wp[i] = p; l += p; }
        l = wave_sum(l);
        __builtin_amdgcn_s_waitcnt(0xC07F); __builtin_amdgcn_wave_barrier();
        float acc = 0.f; int bi = 0;
        for (unsigned mm = mask; mm; mm &= mm - 1u) { const int n = __builtin_ctz(mm); const bf16* vr = F.V + (size_t)(b * SEQ + n * MB) * 512 + h * 64 + lane;
            for (int j = 0; j < 256; ++j) acc = fmaf(wp[bi * 256 + j], bf2f(vr[(size_t)j * 512]), acc);
            ++bi; }
        F.AP[(size_t)m * D + h * 64 + lane] = (bf16)f2bf(acc / l);
        __builtin_amdgcn_s_waitcnt(0xC07F); __builtin_amdgcn_wave_barrier();
    }
}
__device__ __forceinline__ void golden_pool(Frame& F) {
    LAS float* mx = (LAS float*)(F.lds) + F.wave * 128;
    const int gw = F.bid * NWAVES + F.wave, NGW = F.G * NWAVES, lane = F.lane;
    for (int it = gw; it < M * NG; it += NGW) {
        const int m = it >> 2, g = it & 3, t = m % SEQ, w = 2 << g, cnt = (t + 1 < w) ? t + 1 : w;
#pragma unroll
        for (int cc = 0; cc < 2; ++cc) { const int c = lane + 64 * cc; float s = 0.f;
            for (int j = 0; j < cnt; ++j) s += bf2f(F.U[(size_t)(m - j) * 512 + g * 128 + c]);
            mx[c] = s / (float)cnt - bf2f(F.U[(size_t)m * 512 + g * 128 + c]); }
        __builtin_amdgcn_s_waitcnt(0xC07F); __builtin_amdgcn_wave_barrier();
#pragma unroll
        for (int cc = 0; cc < 2; ++cc) { const int d = lane + 64 * cc; float a = 0.f; const float* wpp = F.w_pool + (size_t)g * PG * PG + d;
            for (int c = 0; c < PG; ++c) a = fmaf(mx[c], wpp[(size_t)c * PG], a);
            F.AP[(size_t)m * D + 512 + g * 128 + d] = (bf16)f2bf(a * F.pool_scale[g * 128 + d]); }
        __builtin_amdgcn_s_waitcnt(0xC07F); __builtin_amdgcn_wave_barrier();
    }
}

__device__ __forceinline__ void p0_transpose_item(const float* W, int K, int N, bf16* WT, int row_off, LAS float* scr, int item, int lane, const float* kscale, const float* nscale) {
    const int nblk = N / 32, kb = item / nblk, nb = item % nblk, k0 = 64 * kb, n0 = 32 * nb;
    const float ns = nscale ? nscale[n0 + (lane & 31)] : 1.f;
#pragma unroll 8
    for (int i = 0; i < 32; ++i) { const int kk = 2 * i + (lane >> 5); const float ks = kscale ? kscale[k0 + kk] : 1.f; scr[kk * 33 + (lane & 31)] = W[(size_t)(k0 + kk) * N + n0 + (lane & 31)] * ks * ns; }
    LDS_WAIT(); asm volatile("" ::: "memory");
    const int c = lane & 7;
#pragma unroll
    for (int j = 0; j < 4; ++j) { const int n = (lane >> 3) + 8 * j; const LAS float* s = scr + (8 * c) * 33 + n;
        v4u o; o.x = pk2(s[0 * 33], s[1 * 33]); o.y = pk2(s[2 * 33], s[3 * 33]); o.z = pk2(s[4 * 33], s[5 * 33]); o.w = pk2(s[6 * 33], s[7 * 33]);
        *(GAS v4u*)(WT + (size_t)(row_off + n0 + n) * K + k0 + 8 * c) = o; }
    LDS_WAIT(); asm volatile("" ::: "memory");
}
__device__ __forceinline__ void p0_prologue(Frame& F) {
    LAS float* scr = (LAS float*)(F.lds + RING_OFF + F.wave * 16384);
    const int gw = F.vcu * NWAVES + F.wave, NGW = F.G * NWAVES;
    constexpr int I_IN = (D / 64) * (INW / 32), I_OUT = (D / 64) * (D / 32), I_UP = (D / 64) * (FF / 32), I_DN = (FF / 64) * (D / 32), I_P = (PG / 64) * (PG / 32);
    constexpr int NITEMS = I_IN + I_OUT + I_UP + I_DN + NG * I_P;
    for (int it = gw; it < NITEMS; it += NGW) {
        int r = it;
        if (r < I_IN) { p0_transpose_item(F.w_in, D, INW, F.WinT, 0, scr, r, F.lane, nullptr, nullptr); continue; } r -= I_IN;
        if (r < I_OUT) { p0_transpose_item(F.w_out, D, D, F.WoutT, 0, scr, r, F.lane, nullptr, nullptr); continue; } r -= I_OUT;
        if (r < I_UP) { p0_transpose_item(F.w_up, D, FF, F.WupT, 0, scr, r, F.lane, F.norm_mlp, nullptr); continue; } r -= I_UP;
        if (r < I_DN) { p0_transpose_item(F.w_down, FF, D, F.WdnT, 0, scr, r, F.lane, nullptr, nullptr); continue; } r -= I_DN;
        { const int g = r / I_P; p0_transpose_item(F.w_pool + (size_t)g * PG * PG, PG, PG, F.WpT, g * PG, scr, r % I_P, F.lane, nullptr, F.pool_scale + g * PG); }
    }
    rms_rows_to_bf16(F, F.x, F.norm_mix, F.XN);
}
constexpr int N_PHASES = 8;
constexpr int N_LAUNCHES = MK_N_LAUNCHES;
struct Args { const float* in[10]; float* out; unsigned char* ws; int ph_lo, ph_hi, li, pad; };
__global__ void __launch_bounds__(NWAVES * 64, 2) skel_fwd(Args args) {
    extern __shared__ __attribute__((aligned(16))) unsigned char lds[];
    Frame F;
    F.lds = (LAS unsigned char*)lds;
    F.MISC = (volatile LAS unsigned*)(F.lds + MISC_OFF);
    F.tid = threadIdx.x; F.lane = F.tid & 63; F.wave = __builtin_amdgcn_readfirstlane(F.tid >> 6); F.bid = blockIdx.x; F.G = gridDim.x;
    { const int bx = blockIdx.x; F.vcu = (F.G % 8 == 0) ? (bx % 8) * (F.G / 8) + bx / 8 : bx; }
    F.x = args.in[0]; F.norm_mix = args.in[1]; F.w_in = args.in[2]; F.w_pool = args.in[3]; F.pool_scale = args.in[4]; F.w_out = args.in[5];
    F.norm_mlp = args.in[6]; F.w_up = args.in[7]; F.w_down = args.in[8]; F.norm_final = args.in[9];
    F.out = args.out; F.ws = args.ws;
    unsigned char* ws = args.ws;
    F.ctl = (gu32*)(ws + WS_CTL);
    F.WinT = (bf16*)(ws + WS_WIN); F.WoutT = (bf16*)(ws + WS_WOUT); F.WupT = (bf16*)(ws + WS_WUP); F.WdnT = (bf16*)(ws + WS_WDN); F.WpT = (bf16*)(ws + WS_WP);
    F.Q = (bf16*)(ws + WS_Q); F.K = (bf16*)(ws + WS_K); F.V = (bf16*)(ws + WS_V); F.U = (bf16*)(ws + WS_U); F.AP = (bf16*)(ws + WS_AP); F.H = (bf16*)(ws + WS_H); F.XN = (bf16*)(ws + WS_XN);
    F.KM = (float*)(ws + WS_KM); F.SSQ1 = (float*)(ws + WS_CTL + CTL_SSQ1); F.SSQ2 = (float*)(ws + WS_CTL + CTL_SSQ2);
    for (int u = F.tid; u < (LDS_BYTES - LDSCTL_OFF) / 4; u += NWAVES * 64) ((LAS unsigned*)(F.lds + LDSCTL_OFF))[u] = 0u;
    __syncthreads();
    XcdBarrier bar; bar.bar = (unsigned*)(F.ctl + CW_BAR); bar.x = 0; bar.st = nullptr;
    if (N_LAUNCHES == 1) bar = xcd_barrier_post((unsigned*)(F.ctl + CW_BAR), F.MISC + 8);
#define GRID_BAR(seam) do { if (N_LAUNCHES != 1) { if (F.tid == 0) __hip_atomic_store(F.ctl + CW_TMO, 0xBADBA0u | (unsigned)(seam), RLX_AGENT); } else { xcd_barrier(bar); } } while (0)
    const int lo = args.ph_lo, hi = args.ph_hi;
#define IN(k) (lo <= (k) && (k) < hi)
#define BOTH(k) (IN(k) && IN((k) + 1))

    if (IN(0)) { p0_prologue(F); if (BOTH(0)) GRID_BAR(0); }

    if (IN(1)) {
#if G_P1
        { GEpiInproj E{F.Q, F.K, F.V, F.U}; golden_gemm(F, F.XN, F.w_in, nullptr, M, INW, D, E); }
#else
        { pg8::Gemm g{F.XN, F.WinT, M, INW, D}; pg8::StaticOrder S; S.init(M, INW, F.G, (int)blockIdx.x);
          pg8::EpiInproj E{F.Q, (size_t)(WS_K - WS_Q) / 2, C2, F.KM};
          pg8::gemm_phase<pg8::EpiInproj, pg8::StaticOrder, true, true>(F.lds + RING_OFF, g, S, E); }
#endif
        if (BOTH(1)) GRID_BAR(1);
    }
    if (IN(2)) {
#if G_P1
        golden_kmean(F); if (BOTH(2)) GRID_BAR(2);
#endif
    }
    if (IN(3)) {
#if G_P3
        golden_attention(F); __syncthreads(); golden_pool(F);
#endif
        if (BOTH(3)) GRID_BAR(3);
    }
    if (IN(4)) {
#if G_P4
        { GEpiOut E{F.x, F.out, F.XN, F.SSQ1}; golden_gemm(F, F.AP, F.w_out, nullptr, M, D, D, E); }
#else
        { pg8::Gemm g{F.AP, F.WoutT, M, D, D}; pg8::StaticOrder S; S.init(M, D, F.G, (int)blockIdx.x);
          pg8::EpiRes<true> E{F.x, F.out, F.XN, F.SSQ1, D};
          pg8::gemm_phase<pg8::EpiRes<true>, pg8::StaticOrder, false, true>(F.lds + RING_OFF, g, S, E); }
#endif
        if (BOTH(4)) GRID_BAR(4);
    }
    if (IN(5)) {
#if G_P5
        { GEpiUp E{F.H, F.SSQ1}; golden_gemm(F, F.XN, F.w_up, F.norm_mlp, M, FF, D, E); }
#else
        { pg8::Gemm g{F.XN, F.WupT, M, FF, D}; pg8::StaticOrder S; S.init(M, FF, F.G, (int)blockIdx.x);
          pg8::EpiUp E{F.H, FF, F.SSQ1, 1.f / D, EPS};
          pg8::gemm_phase<pg8::EpiUp, pg8::StaticOrder, true, true>(F.lds + RING_OFF, g, S, E); }
#endif
        if (BOTH(5)) GRID_BAR(5);
    }
    if (IN(6)) {
#if G_P6
        { GEpiDown E{F.out, F.SSQ2}; golden_gemm(F, F.H, F.w_down, nullptr, M, D, FF, E); }
#else
        { pg8::Gemm g{F.H, F.WdnT, M, D, FF}; pg8::StaticOrder S; S.init(M, D, F.G, (int)blockIdx.x);
          pg8::EpiRes<false> E{F.out, F.out, nullptr, F.SSQ2, D};
          pg8::gemm_phase<pg8::EpiRes<false>, pg8::StaticOrder, false, true>(F.lds + RING_OFF, g, S, E); }
#endif
        if (BOTH(6)) GRID_BAR(6);
    }
    if (IN(7)) { final_norm_rows(F, F.out, F.SSQ2, F.norm_final); }
#undef IN
#undef BOTH
}

extern "C" void kernel_launch(void* const* d_in, const int* in_sizes, int n_in, void* d_out, int out_size, void* d_ws, size_t ws_size, hipStream_t stream) {
    static int grid = 0;
    if (grid == 0) {
        if (n_in != 10 || in_sizes[0] != M * D || out_size != M * D || ws_size < WS_END) { fprintf(stderr, "kernel_launch: unexpected shapes (n_in %d in0 %d out %d ws %zu)\n", n_in, n_in > 0 ? in_sizes[0] : -1, out_size, ws_size); grid = -1; return; }
        int dev = 0, cus = 0;
        if (hipGetDevice(&dev) != hipSuccess || hipDeviceGetAttribute(&cus, hipDeviceAttributeMultiprocessorCount, dev) != hipSuccess) { grid = -1; return; }
        if (hipFuncSetAttribute((const void*)skel_fwd, hipFuncAttributeMaxDynamicSharedMemorySize, LDS_BYTES) != hipSuccess) { fprintf(stderr, "kernel_launch: hipFuncSetAttribute failed\n"); grid = -1; return; }
        (void)hipGetLastError();
        grid = cus;
    }
    if (grid < 0) return;
    if (hipMemsetAsync((char*)d_ws + WS_CTL, 0, CTL_ZERO_BYTES, stream) != hipSuccess) return;
    Args a{};
    for (int i = 0; i < 10; ++i) a.in[i] = (const float*)d_in[i];
    a.out = (float*)d_out; a.ws = (unsigned char*)d_ws;
    if (N_LAUNCHES == 1) { a.ph_lo = 0; a.ph_hi = N_PHASES; a.li = 0; hipLaunchKernelGGL(skel_fwd, dim3(grid), dim3(NWAVES * 64), LDS_BYTES, stream, a); }
    else for (int ph = 0; ph < N_PHASES; ++ph) {
        if (ph == 2 && !G_P1) continue;
        a.ph_lo = ph; a.ph_hi = ph + 1; a.li = ph;
        hipLaunchKernelGGL(skel_fwd, dim3(grid), dim3(NWAVES * 64), LDS_BYTES, stream, a);
    }
}
```

```cpp
#include <hip/hip_runtime.h>
#include <cstdio>
#include <cstdint>

#ifndef MK_N_LAUNCHES
#define MK_N_LAUNCHES 1
#endif
#ifndef G_P1
#define G_P1 0
#endif
#ifndef G_P3
#define G_P3 0
#endif
#ifndef G_P4
#define G_P4 0
#endif
#ifndef G_P5
#define G_P5 0
#endif
#ifndef G_P6
#define G_P6 0
#endif

constexpr int BATCH = 4, SEQ = 4096, D = 1024, NH = 8, HD = 64, AW = 512, PW = 512, NG = 4, PG = 128, INW = 2048, FF = 4096;
constexpr int M = BATCH * SEQ;
constexpr int MB = 256, NBLK = SEQ / MB;
constexpr float EPS = 1e-6f;
constexpr float LOG2E = 1.4426950408889634f;
constexpr float C2 = 0.125f * LOG2E;

constexpr size_t MiB = 1u << 20;
constexpr size_t WS_CTL = 0, CTL_ZERO_BYTES = 1 * MiB;
constexpr size_t WS_WIN = 2 * MiB, WS_WOUT = 6 * MiB, WS_WUP = 8 * MiB, WS_WDN = 16 * MiB, WS_WP = 24 * MiB;
constexpr size_t WS_KM = 25 * MiB;
constexpr size_t WS_SSQ1 = 26 * MiB, WS_SSQ2 = 27 * MiB;
constexpr size_t WS_Q = 32 * MiB, WS_K = 48 * MiB, WS_V = 64 * MiB, WS_U = 80 * MiB;
constexpr size_t WS_AP = 96 * MiB;
constexpr size_t WS_H = 32 * MiB;
constexpr size_t WS_XN = 160 * MiB;
constexpr size_t WS_END = 192 * MiB;
static_assert(WS_K - WS_Q == WS_V - WS_K && WS_V - WS_K == WS_U - WS_V, "Q|K|V|U equally spaced");
constexpr int CW_TMO = 0, CW_CODE = 1;
constexpr int CW_BAR = 4096;
constexpr size_t CTL_SSQ1 = 256 * 1024, CTL_SSQ2 = 512 * 1024;

constexpr int NWAVES = 8;
constexpr int RING_OFF = 0, RING_BYTES = 131072;
constexpr int LDSCTL_OFF = RING_BYTES, MISC_OFF = LDSCTL_OFF + 320;
constexpr int LDS_BYTES = 147456;
namespace pg8 {
#define PG8_LAS __attribute__((address_space(3)))
typedef unsigned short bf16_t;
typedef short bf16x8 __attribute__((ext_vector_type(8)));
typedef float f32x4 __attribute__((ext_vector_type(4)));
typedef unsigned u32x4 __attribute__((ext_vector_type(4)));
constexpr int BM = 256, BK = 64, HALF = 128, HTB = HALF * BK * 2  , STAGE_BYTES = 8 * HTB, NXCD = 8, WGM = 8;

__host__ __device__ __forceinline__ int lds_byte(int r, int c) { const int st = (r >> 4) * 2 + (c >> 5), rr = r & 15, cc = c & 31, ob = rr * 64 + cc * 2; return st * 1024 + (ob ^ (((ob >> 9) & 1) << 5)); }
__host__ __device__ __forceinline__ void stage_rc(int b, int& R, int& C) { const int st = b / 1024, sb = b % 1024, swz = sb ^ (((sb >> 9) & 1) << 5); R = (st >> 1) * 16 + swz / 64; C = (st & 1) * 32 + (swz % 64) / 2; }
__host__ __device__ __forceinline__ int perm32(int rho) { const int n = rho >> 4, i = rho & 15; return 8 * (i >> 2) + 4 * n + (i & 3); }

struct Unit { int pm, pn; };
struct Gemm { const bf16_t* A; const bf16_t* Bt; int M, N, K; };

struct StaticOrder {
    int nM, nN, nwg, G, c;
    __host__ __device__ void init(int M, int N, int G_, int c_) { nM = M / BM; nN = N / BM; nwg = nM * nN; G = G_; c = c_; }
    __host__ __device__ bool next(int i, Unit& u) const {
        const long L = (long)i * G + c; if (L >= nwg) return false;
        int wgid = (int)L; { const int q = nwg / NXCD, r = nwg % NXCD, xcd = wgid % NXCD, off = wgid / NXCD; wgid = (xcd < r ? xcd * (q + 1) : r * (q + 1) + (xcd - r) * q) + off; }
        const int nig = WGM * nN, gid = wgid / nig, fm = gid * WGM, gsz = (nM - fm) < WGM ? (nM - fm) : WGM;
        u.pm = fm + ((wgid % nig) % gsz); u.pn = (wgid % nig) / gsz; return true;
    }
    __device__ __forceinline__ void a_ready(const Unit&) const {}
    __device__ __forceinline__ void done(const Unit&) const {}
};


__device__ __forceinline__ unsigned cvt_pk_bf16(float lo, float hi) { unsigned r; asm volatile("v_cvt_pk_bf16_f32 %0, %1, %2" : "=v"(r) : "v"(lo), "v"(hi)); return r; }
typedef unsigned u32x2 __attribute__((ext_vector_type(2)));

struct EpiInproj {
    static constexpr bool PERM = true, AFTER_DRAIN = false;
    bf16_t* O; size_t split_stride; float scale0; float* KM;
    __device__ __forceinline__ void operator()(const f32x4 (&acc)[2][2][4][2], const Unit& u, int wr, int wc, int fr, int fq) const {
        const int row0 = u.pm * BM + wr * 64 + fr, t = u.pn >> 1, colt = (u.pn & 1) * BM;
        bf16_t* base = O + (size_t)t * split_stride; const float sc = (t == 0) ? scale0 : 1.f;
        const int col0 = colt + wc * 32 + 8 * fq;
#pragma unroll
        for (int ai = 0; ai < 2; ++ai)
#pragma unroll
            for (int m = 0; m < 4; ++m) { bf16_t* rowp = base + (size_t)(row0 + ai * HALF + m * 16) * 512 + col0;
#pragma unroll
                for (int bj = 0; bj < 2; ++bj) { const f32x4 v0 = acc[ai][bj][m][0] * sc, v1 = acc[ai][bj][m][1] * sc;
                    u32x4 w; w.x = cvt_pk_bf16(v0[0], v0[1]); w.y = cvt_pk_bf16(v0[2], v0[3]); w.z = cvt_pk_bf16(v1[0], v1[1]); w.w = cvt_pk_bf16(v1[2], v1[3]);
                    *(u32x4*)(rowp + bj * HALF) = w; } }
        if (t == 1) {
#pragma unroll
            for (int bj = 0; bj < 2; ++bj)
#pragma unroll
                for (int n = 0; n < 2; ++n) { f32x4 s = (f32x4){0.f, 0.f, 0.f, 0.f};
#pragma unroll
                    for (int ai = 0; ai < 2; ++ai)
#pragma unroll
                        for (int m = 0; m < 4; ++m) s += acc[ai][bj][m][n];
                    f32x4 r;
#pragma unroll
                    for (int j = 0; j < 4; ++j) { float x = s[j]; x += __shfl_xor(x, 1); x += __shfl_xor(x, 2); x += __shfl_xor(x, 4); x += __shfl_xor(x, 8); r[j] = x; }
                    if (fr == 0) *(f32x4*)(KM + (size_t)(u.pm * 2 + wr) * 512 + col0 + bj * HALF + 4 * n) = r; }
        }
    }
};
struct EpiUp {
    static constexpr bool PERM = true, AFTER_DRAIN = false;
    bf16_t* O; int ldc; const float* SSQ; float inv_n, eps;
    __device__ __forceinline__ void operator()(const f32x4 (&acc)[2][2][4][2], const Unit& u, int wr, int wc, int fr, int fq) const {
        const int row0 = u.pm * BM + wr * 64 + fr, col0 = u.pn * BM + wc * 32 + 8 * fq;
#pragma unroll
        for (int ai = 0; ai < 2; ++ai)
#pragma unroll
            for (int m = 0; m < 4; ++m) { const int row = row0 + ai * HALF + m * 16; const f32x4 s = *(const f32x4*)(SSQ + (size_t)row * 4);
                const float rstd = __builtin_amdgcn_rsqf(((s[0] + s[1]) + (s[2] + s[3])) * inv_n + eps); bf16_t* rowp = O + (size_t)row * ldc + col0;
#pragma unroll
                for (int bj = 0; bj < 2; ++bj) { f32x4 v0 = acc[ai][bj][m][0] * rstd, v1 = acc[ai][bj][m][1] * rstd;
#pragma unroll
                    for (int j = 0; j < 4; ++j) { const float a = __builtin_fmaxf(v0[j], 0.f), b = __builtin_fmaxf(v1[j], 0.f); v0[j] = a * a; v1[j] = b * b; }
                    u32x4 w; w.x = cvt_pk_bf16(v0[0], v0[1]); w.y = cvt_pk_bf16(v0[2], v0[3]); w.z = cvt_pk_bf16(v1[0], v1[1]); w.w = cvt_pk_bf16(v1[2], v1[3]);
                    *(u32x4*)(rowp + bj * HALF) = w; } }
    }
};
template <bool WB> struct EpiRes {
    static constexpr bool PERM = false, AFTER_DRAIN = true;
    const float* base; float* out; bf16_t* xb; float* SSQ; int ldc;
    __device__ __forceinline__ void fused(f32x4 (&acc)[2][2][4][2], const Unit& u, int wr, int wc, int fr, int fq, PG8_LAS unsigned char* lds, int wid, int lane) const {
        PG8_LAS float* P = (PG8_LAS float*)lds;
        const int col0 = u.pn * BM + wc * 32 + 4 * fq;
#pragma unroll
        for (int ai = 0; ai < 2; ++ai)
#pragma unroll
            for (int m = 0; m < 4; ++m) { const int r = ai * HALF + wr * 64 + m * 16 + fr; const size_t off = (size_t)(u.pm * BM + r) * ldc + col0; float q = 0.f;
#pragma unroll
                for (int bj = 0; bj < 2; ++bj)
#pragma unroll
                    for (int n = 0; n < 2; ++n) { const f32x4 bs = *(const f32x4*)(base + off + bj * HALF + n * 16); const f32x4 x = bs + acc[ai][bj][m][n];
                        *(f32x4*)(out + off + bj * HALF + n * 16) = x; q += (x[0] * x[0] + x[1] * x[1]) + (x[2] * x[2] + x[3] * x[3]);
                        if (WB) { u32x2 w; w.x = cvt_pk_bf16(x[0], x[1]); w.y = cvt_pk_bf16(x[2], x[3]); *(u32x2*)(xb + off + bj * HALF + n * 16) = w; } }
                q += __shfl_xor(q, 16); q += __shfl_xor(q, 32);
                if (fq == 0) P[r * 4 + wc] = q;
                if (m & 1) asm volatile("" ::: "memory"); }
        asm volatile("s_waitcnt lgkmcnt(0)" ::: "memory"); __builtin_amdgcn_s_barrier(); asm volatile("" ::: "memory");
        const int row = wid * 32 + (lane & 31);
        if (lane < 32) SSQ[(size_t)(u.pm * BM + row) * 4 + u.pn] = (P[row * 4 + 0] + P[row * 4 + 1]) + (P[row * 4 + 2] + P[row * 4 + 3]);
    }
};
template <class Epi, class Sched, bool ALIGN_EPI = false, bool SP2 = false>
__device__ __forceinline__ void gemm_phase(PG8_LAS unsigned char* lds, const Gemm g, const Sched& S, const Epi& E) {
    const int tid = threadIdx.x, wid = __builtin_amdgcn_readfirstlane(tid >> 6), lane = tid & 63, wr = wid >> 2, wc = wid & 3, fr = lane & 15, fq = lane >> 4;
    const int K = g.K, nt = K / BK;
    unsigned voffA[2], voffB[2];
#pragma unroll
    for (int i = 0; i < 2; ++i) { int R, C; stage_rc(tid * 16 + i * 8192, R, C); const int Rb = Epi::PERM ? ((R & ~31) + perm32(R & 31)) : R;
        voffA[i] = (unsigned)(R * K + C) * 2u; voffB[i] = (unsigned)(Rb * K + C) * 2u; }
    const size_t kstep = (size_t)(BK * 2);
    const size_t hstep = (size_t)HALF * K * 2;
    const size_t tstep = 2 * hstep;
    const unsigned ldsw = (unsigned)wid * 1024u;
    const int aoff = lds_byte(wr * 64 + fr, fq * 8), boff = lds_byte(wc * 32 + fr, fq * 8);
#define PG8_SA(b, h) (((b) * 2 + (h)) * HTB)
#define PG8_SB(b, h) ((4 + (b) * 2 + (h)) * HTB)
#define PG8_STAGE(bufoff, gbase, voff) do { _Pragma("unroll") for (int _i = 0; _i < 2; ++_i) \
        __builtin_amdgcn_global_load_lds((const unsigned*)((const char*)(gbase) + (voff)[_i]), (PG8_LAS unsigned*)(lds + (bufoff) + ldsw + _i * 8192), 16, 0, 0); } while (0)
#define PG8_LDA(dst, b, h) do { _Pragma("unroll") for (int m = 0; m < 4; ++m) _Pragma("unroll") for (int k = 0; k < 2; ++k) dst[m][k] = *(const PG8_LAS bf16x8*)(lds + PG8_SA(b, h) + aoff + m * 2048 + k * 1024); } while (0)
#define PG8_LDB(dst, b, h) do { _Pragma("unroll") for (int n = 0; n < 2; ++n) _Pragma("unroll") for (int k = 0; k < 2; ++k) dst[n][k] = *(const PG8_LAS bf16x8*)(lds + PG8_SB(b, h) + boff + n * 2048 + k * 1024); } while (0)
#define PG8_MMA(ai, bj, At, Bt) do { __builtin_amdgcn_s_setprio(1); _Pragma("unroll") for (int m = 0; m < 4; ++m) _Pragma("unroll") for (int n = 0; n < 2; ++n) _Pragma("unroll") for (int k = 0; k < 2; ++k) \
        acc[ai][bj][m][n] = __builtin_amdgcn_mfma_f32_16x16x32_bf16(Bt[n][k], At[m][k], acc[ai][bj][m][n], 0, 0, 0); __builtin_amdgcn_s_setprio(0); } while (0)
#define PG8_WAIT_V(n) asm volatile("s_waitcnt vmcnt(" #n ")" ::: "memory")
#define PG8_WAIT_L(n) asm volatile("s_waitcnt lgkmcnt(" #n ")" ::: "memory")
#define PG8_BAR __builtin_amdgcn_s_barrier()
#define PG8_SCHED __builtin_amdgcn_sched_barrier(0)
    Unit cur, nxt; int ui = 0;
    if (!S.next(0, cur)) return;
    f32x4 acc[2][2][4][2];
#pragma unroll
    for (int a = 0; a < 2; ++a)
#pragma unroll
        for (int b = 0; b < 2; ++b)
#pragma unroll
            for (int m = 0; m < 4; ++m)
#pragma unroll
                for (int n = 0; n < 2; ++n) acc[a][b][m][n] = (f32x4){0.f, 0.f, 0.f, 0.f};
    bf16x8 At[4][2], B0[2][2], B1[2][2];
    const char* cA = (const char*)g.A + (size_t)cur.pm * tstep; const char* cB = (const char*)g.Bt + (size_t)cur.pn * tstep;
    S.a_ready(cur);
    if constexpr (SP2) {
        PG8_STAGE(PG8_SB(0, 0), cB, voffB); PG8_STAGE(PG8_SB(0, 1), cB + hstep, voffB); PG8_STAGE(PG8_SA(0, 0), cA, voffA); PG8_STAGE(PG8_SA(0, 1), cA + hstep, voffA);
        if (wr == 1) PG8_BAR;
        PG8_WAIT_V(2); PG8_BAR;
        PG8_STAGE(PG8_SB(1, 0), cB + kstep, voffB); PG8_STAGE(PG8_SA(1, 0), cA + kstep, voffA); PG8_STAGE(PG8_SB(1, 1), cB + hstep + kstep, voffB);
        PG8_WAIT_V(6); PG8_BAR;
    } else {
        PG8_STAGE(PG8_SB(0, 0), cB, voffB); PG8_STAGE(PG8_SA(0, 0), cA, voffA); PG8_STAGE(PG8_SB(0, 1), cB + hstep, voffB); PG8_STAGE(PG8_SA(0, 1), cA + hstep, voffA);
        if (wr == 1) PG8_BAR;
        PG8_WAIT_V(4); PG8_BAR;
        PG8_STAGE(PG8_SB(1, 0), cB + kstep, voffB); PG8_STAGE(PG8_SA(1, 0), cA + kstep, voffA); PG8_STAGE(PG8_SB(1, 1), cB + hstep + kstep, voffB);
        PG8_WAIT_V(6); PG8_BAR;
    }
    for (;;) {
        const bool has_next = S.next(ui + 1, nxt);
        const char* nA = has_next ? (const char*)g.A + (size_t)nxt.pm * tstep : cA; const char* nB = has_next ? (const char*)g.Bt + (size_t)nxt.pn * tstep : cB;
        for (int t = 0; t < nt; t += 2) {
            const bool last = (t == nt - 2);
            const char* a1 = cA + (size_t)(t + 1) * kstep;
            const char* a2 = last ? nA : cA + (size_t)(t + 2) * kstep; const char* b2 = last ? nB : cB + (size_t)(t + 2) * kstep;
            const char* a3 = a2 + kstep; const char* b3 = b2 + kstep;
            if (last && has_next) S.a_ready(nxt);
            if constexpr (SP2) {
            PG8_LDB(B0, 0, 0); PG8_LDB(B1, 0, 1); PG8_SCHED; PG8_LDA(At, 0, 0); PG8_STAGE(PG8_SA(1, 1), a1 + hstep, voffA);
            PG8_WAIT_V(8); PG8_WAIT_L(0); PG8_BAR; PG8_MMA(0, 0, At, B0); PG8_MMA(0, 1, At, B1); PG8_BAR; PG8_SCHED;
            PG8_LDA(At, 0, 1); PG8_STAGE(PG8_SB(0, 0), b2, voffB); PG8_STAGE(PG8_SB(0, 1), b2 + hstep, voffB); PG8_STAGE(PG8_SA(0, 0), a2, voffA);
            PG8_WAIT_V(8); PG8_WAIT_L(0); PG8_BAR; PG8_MMA(1, 0, At, B0); PG8_MMA(1, 1, At, B1); PG8_BAR; PG8_SCHED;
            PG8_LDB(B0, 1, 0); PG8_LDB(B1, 1, 1); PG8_SCHED; PG8_LDA(At, 1, 0); PG8_STAGE(PG8_SA(0, 1), a2 + hstep, voffA);
            PG8_WAIT_V(8); PG8_WAIT_L(0); PG8_BAR; PG8_MMA(0, 0, At, B0); PG8_MMA(0, 1, At, B1); PG8_BAR; PG8_SCHED;
            PG8_LDA(At, 1, 1); PG8_STAGE(PG8_SB(1, 0), b3, voffB); PG8_STAGE(PG8_SB(1, 1), b3 + hstep, voffB); PG8_STAGE(PG8_SA(1, 0), a3, voffA);
            PG8_WAIT_V(8); PG8_WAIT_L(0); PG8_BAR; PG8_MMA(1, 0, At, B0); PG8_MMA(1, 1, At, B1); PG8_BAR; PG8_SCHED;
            } else {
            PG8_LDB(B0, 0, 0); PG8_SCHED; PG8_LDA(At, 0, 0); PG8_STAGE(PG8_SA(1, 1), a1 + hstep, voffA);
            PG8_WAIT_L(8); PG8_BAR; PG8_WAIT_L(0); PG8_MMA(0, 0, At, B0); PG8_BAR; PG8_SCHED;
            PG8_LDB(B1, 0, 1); PG8_STAGE(PG8_SB(0, 0), b2, voffB);
            PG8_BAR; PG8_WAIT_L(0); PG8_MMA(0, 1, At, B1); PG8_BAR;
            PG8_LDA(At, 0, 1); PG8_STAGE(PG8_SA(0, 0), a2, voffA);
            PG8_BAR; PG8_WAIT_L(0); PG8_MMA(1, 0, At, B0); PG8_BAR; PG8_SCHED;
            PG8_STAGE(PG8_SB(0, 1), b2 + hstep, voffB);
            PG8_WAIT_V(6); PG8_BAR; PG8_MMA(1, 1, At, B1); PG8_BAR;
            PG8_LDB(B0, 1, 0); PG8_SCHED; PG8_LDA(At, 1, 0); PG8_STAGE(PG8_SA(0, 1), a2 + hstep, voffA);
            PG8_WAIT_L(8); PG8_BAR; PG8_WAIT_L(0); PG8_MMA(0, 0, At, B0); PG8_BAR; PG8_SCHED;
            PG8_LDB(B1, 1, 1); PG8_STAGE(PG8_SB(1, 0), b3, voffB);
            PG8_BAR; PG8_WAIT_L(0); PG8_MMA(0, 1, At, B1); PG8_BAR;
            PG8_LDA(At, 1, 1); PG8_STAGE(PG8_SA(1, 0), a3, voffA);
            PG8_BAR; PG8_WAIT_L(0); PG8_MMA(1, 0, At, B0); PG8_BAR; PG8_SCHED;
            PG8_STAGE(PG8_SB(1, 1), b3 + hstep, voffB);
            PG8_WAIT_V(6); PG8_BAR; PG8_MMA(1, 1, At, B1); PG8_BAR;
            }
        }
        if constexpr (ALIGN_EPI) { if (wr == 0) PG8_BAR; }
        if constexpr (!Epi::AFTER_DRAIN) { E(acc, cur, wr, wc, fr, fq); S.done(cur); }
        if (!has_next) break;
#pragma unroll
        for (int a = 0; a < 2; ++a)
#pragma unroll
            for (int b = 0; b < 2; ++b)
#pragma unroll
                for (int m = 0; m < 4; ++m)
#pragma unroll
                    for (int n = 0; n < 2; ++n) acc[a][b][m][n] = (f32x4){0.f, 0.f, 0.f, 0.f};
        cur = nxt; cA = nA; cB = nB; ++ui;
        if constexpr (ALIGN_EPI) { if (wr == 1) PG8_BAR; }
    }
    PG8_WAIT_V(0);
    if constexpr (!ALIGN_EPI) { if (wr == 0) PG8_BAR; }
    PG8_BAR;
    if constexpr (Epi::AFTER_DRAIN) { E.fused(acc, cur, wr, wc, fr, fq, lds, wid, lane); S.done(cur); }
#undef PG8_SA
#undef PG8_SB
#undef PG8_STAGE
#undef PG8_LDA
#undef PG8_LDB
#undef PG8_MMA
#undef PG8_WAIT_V
#undef PG8_WAIT_L
#undef PG8_BAR
#undef PG8_SCHED
}
}
#include <hip/hip_bf16.h>
#include <cmath>
namespace attn_body {
using bf16=__hip_bfloat16;
using bf16x8=__attribute__((ext_vector_type(8)))short;
using s16x4=__attribute__((ext_vector_type(4)))short;
using f32x16=__attribute__((ext_vector_type(16)))float;
using u32x4=__attribute__((ext_vector_type(4)))unsigned;
using f32x4_t=__attribute__((ext_vector_type(4)))float;
constexpr int BATCH=4,NHEAD=8,SEQ=4096,D=64,DM=NHEAD*D,ODM=1024;
constexpr float LOG2E_=1.4426950408889634f;
constexpr int NW=8,QBLK=32,QB=QBLK*NW,KVBLK=64,NQB=SEQ/QB;
constexpr int ATTN_PITCH=DM, ATTN_UNIT_ROWS=QB;
__device__ __forceinline__ int crow(int r,int hi){return (r&3)+8*(r>>2)+4*hi;}
#define SBAR() __builtin_amdgcn_sched_barrier(0)
__device__ __forceinline__ void cmask(f32x16&p0,f32x16&p1,int jb,int qrel,int hi){
  const float NEG=-INFINITY; int kb=64*jb+4*hi;
  #pragma unroll
  for(int r=0;r<16;++r){int kv=kb+(r&3)+8*(r>>2); if(kv>qrel)p0[r]=NEG; if(kv+32>qrel)p1[r]=NEG;}
}

constexpr int NSLOT=3, SLOTB=8192;
constexpr int LDS_K=0, LDS_V=NSLOT*SLOTB, LDS_WS=2*NSLOT*SLOTB, LDS_OST=LDS_WS+NW*64*4, LDS_BYTES=LDS_OST+NW*4096;
constexpr float C2=0.125f*1.4426950408889634f;
__device__ __forceinline__ void glds16(const void*gsrc,unsigned lds_dst){unsigned keep;
  asm volatile("s_mov_b32 %0, m0\n\ts_mov_b32 m0, %2\n\ts_nop 0\n\tglobal_load_lds_dwordx4 %1, off\n\ts_mov_b32 m0, %0":"=&s"(keep):"v"(gsrc),"s"(lds_dst):"memory");}
__device__ __forceinline__ float max3f(float a,float b,float c){float r;asm("v_max3_f32 %0, %1, %2, %3":"=v"(r):"v"(a),"v"(b),"v"(c));return r;}
__device__ __forceinline__ float max2f(float a,float b){float r;asm("v_max_f32_e32 %0, %1, %2":"=v"(r):"v"(a),"v"(b));return r;}
__device__ __forceinline__ float fadd_s(float a,float b){float r;asm("v_add_f32_e32 %0, %1, %2":"=v"(r):"v"(a),"v"(b));return r;}
__device__ __forceinline__ float fsub_s(float a,float b){float r;asm("v_sub_f32_e32 %0, %1, %2":"=v"(r):"v"(a),"v"(b));return r;}
typedef float f32x2_t __attribute__((ext_vector_type(2))); typedef __bf16 bf16x2_t __attribute__((ext_vector_type(2)));
__device__ __forceinline__ unsigned cvtpk_s(float lo,float hi){f32x2_t v={lo,hi};bf16x2_t b=__builtin_convertvector(v,bf16x2_t);return __builtin_bit_cast(unsigned,b);}
#define WAIT_BAR(N) asm volatile("s_waitcnt vmcnt(" #N ") lgkmcnt(0)\n\ts_barrier":::"memory")

__device__ __forceinline__ void qkt(f32x16&p0,f32x16&p1,const char*Kslot,const bf16x8*qr,int r32,int hi){
  const char*kb=Kslot+hi*1024+r32*16;
  #pragma unroll
  for(int d0=0;d0<4;++d0){
    const bf16x8 b0=*reinterpret_cast<const bf16x8*>(kb+d0*2048);
    const bf16x8 b1=*reinterpret_cast<const bf16x8*>(kb+d0*2048+512);
    p0=__builtin_amdgcn_mfma_f32_32x32x16_bf16(b0,qr[d0],p0,0,0,0);p1=__builtin_amdgcn_mfma_f32_32x32x16_bf16(b1,qr[d0],p1,0,0,0);}
}
typedef __attribute__((address_space(3))) const char* lds_cptr;
typedef short v4i16_t __attribute__((ext_vector_type(4)));
__device__ __forceinline__ void kload8(bf16x8*kf,lds_cptr kp){
  kf[0]=*(const __attribute__((address_space(3))) bf16x8*)(kp);      kf[1]=*(const __attribute__((address_space(3))) bf16x8*)(kp+512);
  kf[2]=*(const __attribute__((address_space(3))) bf16x8*)(kp+2048); kf[3]=*(const __attribute__((address_space(3))) bf16x8*)(kp+2560);
  kf[4]=*(const __attribute__((address_space(3))) bf16x8*)(kp+4096); kf[5]=*(const __attribute__((address_space(3))) bf16x8*)(kp+4608);
  kf[6]=*(const __attribute__((address_space(3))) bf16x8*)(kp+6144); kf[7]=*(const __attribute__((address_space(3))) bf16x8*)(kp+6656);
}
__device__ __forceinline__ void kload2(bf16x8*kf,lds_cptr kp,int j){ kf[2*j]=*(const __attribute__((address_space(3))) bf16x8*)(kp+j*2048); kf[2*j+1]=*(const __attribute__((address_space(3))) bf16x8*)(kp+j*2048+512); }
__device__ __forceinline__ s16x4 vtr(lds_cptr p){ return __builtin_bit_cast(s16x4,__builtin_amdgcn_ds_read_tr16_b64_v4i16((__attribute__((address_space(3))) v4i16_t*)p)); }
__device__ __forceinline__ float rowmax(const f32x16&p0,const f32x16&p1){
  float a=max3f(p0[0],p0[1],p1[0]),b=max3f(p0[2],p0[3],p1[1]);a=max3f(a,p1[2],p1[3]);
  #pragma unroll
  for(int r=4;r<16;r+=4){a=max3f(a,p0[r],p0[r+1]);b=max3f(b,p0[r+2],p0[r+3]);a=max3f(a,p1[r],p1[r+1]);b=max3f(b,p1[r+2],p1[r+3]);}
  const float m=max2f(a,b);
  auto rr=__builtin_amdgcn_permlane32_swap(__float_as_uint(m),__float_as_uint(m),false,false);
  return max2f(__uint_as_float(rr[0]),__uint_as_float(rr[1]));
}
__device__ __forceinline__ void pv(f32x16*o,int vb,bf16x8 pa0,bf16x8 pa1,bf16x8 pa2,bf16x8 pa3){
  #pragma unroll
  for(int d0=0;d0<2;++d0){s16x4 lo[4],hi[4];
    #pragma unroll
    for(int ks=0;ks<4;++ks){
      asm volatile("ds_read_b64_tr_b16 %0,%1 offset:%c2":"=&v"(lo[ks]):"v"(vb),"i"(d0*4096+ks*1024):"memory");
      asm volatile("ds_read_b64_tr_b16 %0,%1 offset:%c2":"=&v"(hi[ks]):"v"(vb),"i"(d0*4096+ks*1024+512):"memory");}
    asm volatile("s_waitcnt lgkmcnt(0)":::"memory");SBAR();
    #define PK(k) (bf16x8){lo[k][0],lo[k][1],lo[k][2],lo[k][3],hi[k][0],hi[k][1],hi[k][2],hi[k][3]}
    o[d0]=__builtin_amdgcn_mfma_f32_32x32x16_bf16(pa0,PK(0),o[d0],0,0,0);
    o[d0]=__builtin_amdgcn_mfma_f32_32x32x16_bf16(pa1,PK(1),o[d0],0,0,0);
    o[d0]=__builtin_amdgcn_mfma_f32_32x32x16_bf16(pa2,PK(2),o[d0],0,0,0);
    o[d0]=__builtin_amdgcn_mfma_f32_32x32x16_bf16(pa3,PK(3),o[d0],0,0,0);
    #undef PK
  }
}

#ifndef ATTN_STORE16
#define ATTN_STORE16(p,v) (*(u32x4*)(p)=(v))
#endif
template<int THRL> __device__ __forceinline__ void attn_unit(int b,int h,int qb,const bf16*Q,const bf16*__restrict__ K,const bf16*__restrict__ V,bf16*O,const float*__restrict__ KM,char*shm){
  const int tid=threadIdx.x,lane=tid&63,r32=lane&31,hi=lane>>5; const int wid=__builtin_amdgcn_readfirstlane(tid>>6);
  const long rowbase=(long)b*SEQ; const int q0=qb*QB;
  const bf16*Qw=Q+(rowbase+q0+wid*QBLK)*DM+h*D;
  const bf16*Kh=K+rowbase*DM+h*D,*Vh=V+rowbase*DM+h*D;
  const unsigned lds0=(unsigned)(uintptr_t)shm;
  float*wsf=(float*)(shm+LDS_WS)+wid*64;
  const bf16*ksrc=Kh+(long)lane*DM+wid*8;
  const bf16*vsrc=Vh+(long)(16*(wid&3)+(lane>>2))*DM+(wid>>2)*32+(lane&3)*8;
  const unsigned kdst=lds0+LDS_K+wid*1024, vdst=lds0+LDS_V+wid*1024;
  #define DMA_K(t,slot) glds16(ksrc+(long)(t)*KVBLK*DM,(unsigned)__builtin_amdgcn_readfirstlane(kdst+(slot)))
  #define DMA_V(t,slot) glds16(vsrc+(long)(t)*KVBLK*DM,(unsigned)__builtin_amdgcn_readfirstlane(vdst+(slot)))
  const int vb0=(int)(lds0+LDS_V)+((lane>>4)&1)*32+(lane&3)*8+(4*hi+((lane&15)>>2))*64;
  const char*Kbase=shm+LDS_K; bf16x8 kf[8];
  const lds_cptr shm3=(lds_cptr)shm; const lds_cptr kp0=shm3+LDS_K+hi*1024+r32*16; const lds_cptr vp0=shm3+LDS_V+((lane>>4)&1)*32+(lane&3)*8+(4*hi+((lane&15)>>2))*64;
  const int NT=(q0+QB)/KVBLK;
  DMA_K(0,0);DMA_V(0,0);DMA_K(1,SLOTB);
  bf16x8 qr[4];
  #pragma unroll
  for(int d0=0;d0<4;++d0)qr[d0]=*reinterpret_cast<const bf16x8*>(&Qw[(long)r32*DM+d0*16+hi*8]);
  float mhat=0.f,l_reg=0.f;f32x16 o[2];o[0]=f32x16{};o[1]=f32x16{};
  const int qrel=wid*QBLK+r32;
  unsigned selmask;
  { bf16x8 kmf[4];
    #pragma unroll
    for(int d0=0;d0<4;++d0){ u32x4 w=(u32x4){0u,0u,0u,0u};
      if(r32<16&&r32<qb){ const float*p=KM+((size_t)(b*(SEQ/QB)+r32)*2)*512+h*D+d0*16+hi*8;
        const f32x4_t a0=*(const f32x4_t*)p,a1=*(const f32x4_t*)(p+4),b0=*(const f32x4_t*)(p+512),b1=*(const f32x4_t*)(p+516);
        const f32x4_t s0=(a0+b0)*(1.0f/256.0f),s1=(a1+b1)*(1.0f/256.0f);
        w=(u32x4){cvtpk_s(s0[0],s0[1]),cvtpk_s(s0[2],s0[3]),cvtpk_s(s1[0],s1[1]),cvtpk_s(s1[2],s1[3])}; }
      kmf[d0]=__builtin_bit_cast(bf16x8,w); }
    f32x16 g=f32x16{};
    #pragma unroll
    for(int d0=0;d0<4;++d0)g=__builtin_amdgcn_mfma_f32_32x32x16_bf16(kmf[d0],qr[d0],g,0,0,0);
    float gv[16]; int gn[16];
    #pragma unroll
    for(int r=0;r<8;++r){ gv[r]=g[r]; gn[r]=crow(r,hi); gv[8+r]=__shfl_xor(g[r],32); gn[8+r]=crow(r,1-hi); }
    #pragma unroll
    for(int j=0;j<16;++j) if(gn[j]>=qb) gv[j]=-INFINITY;
    float thr=-INFINITY;
    if(qb>3){ float m1=-INFINITY,m2=-INFINITY,m3=-INFINITY;
      #pragma unroll
      for(int j=0;j<16;++j)m1=__builtin_fmaxf(m1,gv[j]);
      #pragma unroll
      for(int j=0;j<16;++j)m2=__builtin_fmaxf(m2,gv[j]<m1?gv[j]:-INFINITY);
      #pragma unroll
      for(int j=0;j<16;++j)m3=__builtin_fmaxf(m3,gv[j]<m2?gv[j]:-INFINITY);
      thr=m3; }
    selmask=1u<<qb;
    #pragma unroll
    for(int j=0;j<16;++j) if(gn[j]<qb&&gv[j]>=thr) selmask|=1u<<gn[j];
  }
  const float slope2=__builtin_ldexpf(LOG2E_,-(h+1));
  float cb=slope2*(float)(4*hi-(q0+qrel));
  #define INITC(C0,C1,t) do{ const float ct_=((selmask>>((t)>>2))&1u)?__builtin_fmaf(slope2,(float)(64*(t)),cb):-INFINITY; \
    _Pragma("unroll") for(int r=0;r<16;++r){ C0[r]=__builtin_fmaf(slope2,(float)((r&3)+8*(r>>2)),ct_); C1[r]=__builtin_fmaf(slope2,(float)((r&3)+8*(r>>2)+32),ct_); } }while(0)
  #define CMASK(P0,P1,t) do{int jb_=(t)-(NT-4); if(jb_>=0)cmask(P0,P1,jb_,qrel,hi);}while(0)
  bool resc=false;
  #define START(P0,P1) do{ const float rm=rowmax(P0,P1); resc=false; \
    { const float dl=max2f(rm,0.f); mhat=fadd_s(mhat,dl); cb=fsub_s(cb,dl); \
      _Pragma("unroll") for(int r=0;r<16;++r){P0[r]=fsub_s(P0[r],dl);P1[r]=fsub_s(P1[r],dl);} } \
    _Pragma("unroll") for(int r=0;r<16;++r)P0[r]=__builtin_amdgcn_exp2f(P0[r]); }while(0)
  #define RESC() do{ if(resc){ asm volatile("s_waitcnt lgkmcnt(0)":::"memory"); \
      _Pragma("unroll") for(int d_=0;d_<2;++d_) _Pragma("unroll") for(int r=0;r<16;++r)o[d_][r]*=wsf[crow(r,hi)]; } }while(0)
  f32x16 pA0,pA1,pB0,pB1;
  int sl_prev=0,sl_cur=0,sl_next=SLOTB;
  #define ROT() do{sl_prev=sl_cur;sl_cur=sl_next;sl_next=(sl_next==(NSLOT-1)*SLOTB)?0:sl_next+SLOTB;}while(0)
  DMA_K(2,2*SLOTB);
  WAIT_BAR(3);
  INITC(pA0,pA1,0); qkt(pA0,pA1,Kbase,qr,r32,hi);asm volatile("s_nop 15\n\ts_nop 7":"+v"(pA0),"+v"(pA1));CMASK(pA0,pA1,0);
  START(pA0,pA1);
  _Pragma("unroll") for(int r=0;r<16;++r)pA1[r]=__builtin_amdgcn_exp2f(pA1[r]);
  WAIT_BAR(0);
  DMA_K(3,0);DMA_V(1,SLOTB);
  ROT();
  kload8(kf,kp0+sl_cur);
  WAIT_BAR(2);
  s16x4 vlo[8],vhi[8]; u32x4 pw0,pw1,pw2,pw3;
  #define PKW(P,B) cvtpk_s(P[B],P[B+1])
  #define PAF(k) __builtin_bit_cast(bf16x8,pw##k)
  #define VFR(i) (bf16x8){vlo[i][0],vlo[i][1],vlo[i][2],vlo[i][3],vhi[i][0],vhi[i][1],vhi[i][2],vhi[i][3]}
  #define PIN(x) asm volatile("":"+v"(x))
  #define MX3(a,b,c) __builtin_fmaxf(__builtin_fmaxf((a),(b)),(c))
  #define GAPA(MF,A0,A1,A2,A3,W0,W1,PW) do{ MF; sacc+=A0; sacc+=A1; sacc+=A2; sacc+=A3; PIN(sacc); W0; W1; PIN(PW); SBAR(); }while(0)
  #define EX(v) __builtin_amdgcn_exp2f(v)
  #define GAPB(MF,X,B) do{ MF; X[B]=EX(X[B]); X[B+1]=EX(X[B+1]); X[B+2]=EX(X[B+2]); X[B+3]=EX(X[B+3]); PIN(X); SBAR(); }while(0)
  #define VRD(i) do{ vlo[i]=vtr(vp_+(((i)>>2)*4096+((i)&3)*1024)); vhi[i]=vtr(vp_+(((i)>>2)*4096+((i)&3)*1024+512)); }while(0)
  #define KRD(G,j) do{ if(G){ kload2(kf,kp0+sl_next,j); SBAR(); } }while(0)
  #define STEP(C0,C1,P0,P1,t,GK,GV,GL) do{ SBAR(); INITC(C0,C1,t); SBAR(); \
    const lds_cptr vp_=vp0+sl_prev; \
    VRD(0); SBAR(); float sacc=(P0[0]+P0[1]); \
    GAPA(C0=__builtin_amdgcn_mfma_f32_32x32x16_bf16(kf[0],qr[0],C0,0,0,0), P0[2],P0[3],P0[4],P0[5],     pw0[0]=PKW(P0,0), pw0[1]=PKW(P0,2), pw0); \
    VRD(4); SBAR(); GAPA(C1=__builtin_amdgcn_mfma_f32_32x32x16_bf16(kf[1],qr[0],C1,0,0,0), P0[6],P0[7],P0[8],P0[9],     pw0[2]=PKW(P0,4), pw0[3]=PKW(P0,6), pw0); \
    VRD(1); SBAR(); GAPA(C0=__builtin_amdgcn_mfma_f32_32x32x16_bf16(kf[2],qr[1],C0,0,0,0),   P0[10],P0[11],P0[12],P0[13], pw1[0]=PKW(P0,8), pw1[1]=PKW(P0,10), pw1); \
    VRD(5); SBAR(); GAPA(C1=__builtin_amdgcn_mfma_f32_32x32x16_bf16(kf[3],qr[1],C1,0,0,0),   P0[14],P0[15],P1[0],P1[1],   pw1[2]=PKW(P0,12),pw1[3]=PKW(P0,14), pw1); \
    VRD(2); SBAR(); GAPA(C0=__builtin_amdgcn_mfma_f32_32x32x16_bf16(kf[4],qr[2],C0,0,0,0),   P1[2],P1[3],P1[4],P1[5],     pw2[0]=PKW(P1,0), pw2[1]=PKW(P1,2), pw2); \
    VRD(6); SBAR(); GAPA(C1=__builtin_amdgcn_mfma_f32_32x32x16_bf16(kf[5],qr[2],C1,0,0,0),   P1[6],P1[7],P1[8],P1[9],     pw2[2]=PKW(P1,4), pw2[3]=PKW(P1,6), pw2); \
    VRD(3); SBAR(); GAPA(C0=__builtin_amdgcn_mfma_f32_32x32x16_bf16(kf[6],qr[3],C0,0,0,0),   P1[10],P1[11],P1[12],P1[13], pw3[0]=PKW(P1,8), pw3[1]=PKW(P1,10), pw3); \
    VRD(7); SBAR(); GAPA(C1=__builtin_amdgcn_mfma_f32_32x32x16_bf16(kf[7],qr[3],C1,0,0,0),   P1[14],P1[15],0.f,0.f,       pw3[2]=PKW(P1,12),pw3[3]=PKW(P1,14), pw3); \
    l_reg+=sacc; \
    if(GK){DMA_K((t)+3,sl_cur);} if(GV){DMA_V((t)+1,sl_next);} \
    CMASK(C0,C1,t); \
    { float a=MX3(C0[0],C0[1],C1[0]),b=MX3(C0[2],C0[3],C1[1]); a=MX3(a,C1[2],C1[3]); \
      _Pragma("unroll") for(int r=4;r<16;r+=4){a=MX3(a,C0[r],C0[r+1]);b=MX3(b,C0[r+2],C0[r+3]);a=MX3(a,C1[r],C1[r+1]);b=MX3(b,C1[r+2],C1[r+3]);} \
      float rm=__builtin_fmaxf(a,b); { auto rr=__builtin_amdgcn_permlane32_swap(__float_as_uint(rm),__float_as_uint(rm),false,false); rm=__builtin_fmaxf(__uint_as_float(rr[0]),__uint_as_float(rr[1])); } \
      resc=false; \
      if(__builtin_expect(__any(rm>(float)THRL),0)){ const float dl=__builtin_fmaxf(rm,0.f); mhat+=dl; \
        _Pragma("unroll") for(int r=0;r<16;++r){C0[r]-=dl;C1[r]-=dl;} \
        cb-=dl; \
        const float f=__builtin_amdgcn_exp2f(-dl); l_reg*=f; if(hi==0)wsf[r32]=f; resc=true; } } \
    SBAR(); \
    GAPB(o[0]=__builtin_amdgcn_mfma_f32_32x32x16_bf16(PAF(0),VFR(0),o[0],0,0,0), C0,0); \
    GAPB(o[1]=__builtin_amdgcn_mfma_f32_32x32x16_bf16(PAF(0),VFR(4),o[1],0,0,0), C0,4); \
    KRD(GL,0); GAPB(o[0]=__builtin_amdgcn_mfma_f32_32x32x16_bf16(PAF(1),VFR(1),o[0],0,0,0), C0,8); \
    KRD(GL,1); GAPB(o[1]=__builtin_amdgcn_mfma_f32_32x32x16_bf16(PAF(1),VFR(5),o[1],0,0,0), C0,12); \
    KRD(GL,2); GAPB(o[0]=__builtin_amdgcn_mfma_f32_32x32x16_bf16(PAF(2),VFR(2),o[0],0,0,0), C1,0); \
    KRD(GL,3); GAPB(o[1]=__builtin_amdgcn_mfma_f32_32x32x16_bf16(PAF(2),VFR(6),o[1],0,0,0), C1,4); \
    GAPB(o[0]=__builtin_amdgcn_mfma_f32_32x32x16_bf16(PAF(3),VFR(3),o[0],0,0,0), C1,8); \
    GAPB(o[1]=__builtin_amdgcn_mfma_f32_32x32x16_bf16(PAF(3),VFR(7),o[1],0,0,0), C1,12); \
    }while(0)
  int t=1;
  #undef CMASK
  #define CMASK(P0,P1,t) do{}while(0)
  for(;t+5<NT;t+=2){
    STEP(pB0,pB1,pA0,pA1,t,true,true,true);     WAIT_BAR(2); RESC(); ROT();
    STEP(pA0,pA1,pB0,pB1,t+1,true,true,true);   WAIT_BAR(2); RESC(); ROT();
  }
  #undef CMASK
  #define CMASK(P0,P1,t) do{int jb_=(t)-(NT-4); if(jb_>=0)cmask(P0,P1,jb_,qrel,hi);}while(0)
  #define ENDW(tt) do{ if((tt)+3<NT){WAIT_BAR(2);} else if((tt)+2<NT){WAIT_BAR(1);} else {WAIT_BAR(0);} }while(0)
  for(;t+1<NT;t+=2){
    STEP(pB0,pB1,pA0,pA1,t,(t+3<NT),(t+1<NT),(t+1<NT));       ENDW(t);   RESC(); ROT();
    STEP(pA0,pA1,pB0,pB1,t+1,(t+4<NT),(t+2<NT),(t+2<NT));     ENDW(t+1); RESC(); ROT();
  }
  STEP(pB0,pB1,pA0,pA1,NT-1,false,false,false); RESC();
  { float sacc=pB0[0]+pB0[1]; _Pragma("unroll") for(int r=2;r<16;++r)sacc+=pB0[r]; _Pragma("unroll") for(int r=0;r<16;++r)sacc+=pB1[r]; l_reg+=sacc;
    pw0=(u32x4){PKW(pB0,0),PKW(pB0,2),PKW(pB0,4),PKW(pB0,6)};pw1=(u32x4){PKW(pB0,8),PKW(pB0,10),PKW(pB0,12),PKW(pB0,14)};pw2=(u32x4){PKW(pB1,0),PKW(pB1,2),PKW(pB1,4),PKW(pB1,6)};pw3=(u32x4){PKW(pB1,8),PKW(pB1,10),PKW(pB1,12),PKW(pB1,14)};
    SBAR(); pv(o,vb0+sl_cur,PAF(0),PAF(1),PAF(2),PAF(3)); }
  #undef PKW
  #undef PAF
  #undef VFR
  #undef PIN
  #undef MX3
  #undef GAPA
  #undef GAPB
  #undef EX
  #undef VRD
  #undef KRD
  #undef STEP
  #undef ENDW
  {auto rr=__builtin_amdgcn_permlane32_swap(__float_as_uint(l_reg),__float_as_uint(l_reg),false,false);l_reg=__uint_as_float(rr[0])+__uint_as_float(rr[1]);}
  if(hi==0)wsf[32+r32]=l_reg;asm volatile("s_waitcnt lgkmcnt(0)":::"memory");
  float rli[16];
  #pragma unroll
  for(int r=0;r<16;++r)rli[r]=__builtin_amdgcn_rcpf(wsf[32+crow(r,hi)]);
  bf16*Ow=O+(rowbase+q0+wid*QBLK)*ODM+h*D;
  { bf16*stg=(bf16*)(shm+LDS_OST)+wid*2048;
    #pragma unroll
    for(int r=0;r<16;++r){const int orow=crow(r,hi);
      #pragma unroll
      for(int d0=0;d0<2;++d0)stg[orow*64+d0*32+r32]=__float2bfloat16(o[d0][r]*rli[r]);}
    asm volatile("s_waitcnt lgkmcnt(0)":::"memory");
    #pragma unroll
    for(int i=0;i<4;++i){const int row=i*8+(lane>>3),ch=lane&7; const u32x4 v=*(const u32x4*)(stg+row*64+ch*8); ATTN_STORE16(Ow+(long)row*ODM+ch*8,v);} }
  asm volatile("s_waitcnt lgkmcnt(0)\n\ts_barrier":::"memory");
  #undef DMA_K
  #undef DMA_V
  #undef CMASK
  #undef START
  #undef RESC
  #undef INITC
  #undef ROT
}
constexpr int ATTN_LDS_BYTES=LDS_BYTES;
struct AttnTensors { const bf16* Q; const bf16* K; const bf16* V; bf16* O; const float* KM; };
struct AttnUnit { int bh; int qb; };
struct StaticOrder {
  int vcu;
  __device__ __forceinline__ explicit StaticOrder(int grid,int block):vcu((block%8)*(grid/8)+block/8){}
  __device__ __forceinline__ bool next(int i,AttnUnit&u)const{ if(i>=2)return false; const int s=vcu&7; u.bh=vcu>>3; u.qb=(i==0)?15-s:s; return true; }
  __device__ __forceinline__ void a_ready(const AttnUnit&)const{}
  __device__ __forceinline__ void done(const AttnUnit&)const{}
};
template<class Sched,int THRL=8> __device__ __forceinline__ void attn_phase(char*lds,const AttnTensors&T,const Sched&S){
  AttnUnit u;
  for(int i=0;S.next(i,u);++i){ S.a_ready(u); attn_unit<THRL>(u.bh/NHEAD,u.bh%NHEAD,u.qb,T.Q,T.K,T.V,T.O,T.KM,lds); S.done(u); }
}
#undef SBAR
#undef WAIT_BAR
}
#define GAS __attribute__((address_space(1)))
#define LAS __attribute__((address_space(3)))
typedef unsigned short bf16;
typedef unsigned v4u __attribute__((ext_vector_type(4)));
typedef unsigned v2u __attribute__((ext_vector_type(2)));
typedef float f32x4 __attribute__((ext_vector_type(4)));
typedef GAS unsigned gu32;
#define RLX_AGENT __ATOMIC_RELAXED, __HIP_MEMORY_SCOPE_AGENT
#define LDS_WAIT() asm volatile("s_waitcnt lgkmcnt(0)" ::: "memory")
#define VM_WAIT() asm volatile("s_waitcnt vmcnt(0)" ::: "memory")
__device__ __forceinline__ unsigned f2bf(float f) { unsigned u = __builtin_bit_cast(unsigned, f); return (u + 0x7fffu + ((u >> 16) & 1u)) >> 16; }
__device__ __forceinline__ unsigned pk2(float lo, float hi) { return f2bf(lo) | (f2bf(hi) << 16); }
__device__ __forceinline__ float bf2f(unsigned b) { return __builtin_bit_cast(float, b << 16); }
__device__ __forceinline__ float wave_sum(float v) {
#pragma unroll
    for (int o = 1; o < 64; o <<= 1) v += __shfl_xor(v, o);
    return v;
}
__device__ __forceinline__ float wave_max(float v) {
#pragma unroll
    for (int o = 1; o < 64; o <<= 1) v = fmaxf(v, __shfl_xor(v, o));
    return v;
}
#define XB_TMO      128
#define XB_XCNT(j)  (256  + 64 * (j))
#define XB_XSUB(j)  (1280 + 64 * (j))
#define XB_XGEN(j)  (2304 + 64 * (j))
#define XB_TOP      3328
#define XB_TOPGEN   3392
#define XCD_BAR_WORDS 3456
#define XB_SPIN_CAP (1u << 18)

__device__ __forceinline__ unsigned xb_ld(unsigned* p)              { return __hip_atomic_load(p, __ATOMIC_RELAXED, __HIP_MEMORY_SCOPE_AGENT); }
__device__ __forceinline__ unsigned xb_add(unsigned* p, unsigned v) { return __hip_atomic_fetch_add(p, v, __ATOMIC_RELAXED, __HIP_MEMORY_SCOPE_AGENT); }
__device__ __forceinline__ unsigned xb_xcc_id() { return (unsigned)__builtin_amdgcn_s_getreg((3 << 11) | 20) & 0xFu; }
#define XB_SPIN(cond, bar) do { unsigned _sp = 0; while (cond) { __builtin_amdgcn_s_sleep(1); \
    if ((++_sp & 255u) == 0u) { if (xb_ld(&(bar)[XB_TMO])) break; if (_sp > XB_SPIN_CAP) { atomicAdd(&(bar)[XB_TMO], 1u); break; } } } } while (0)

struct XcdBarrier {
    unsigned* bar; unsigned x;
    volatile LAS unsigned* st;
};

__device__ __forceinline__ XcdBarrier xcd_barrier_post(unsigned* bar, volatile LAS unsigned* st) {
    XcdBarrier b; b.bar = bar; b.x = xb_xcc_id(); b.st = st;
    if (threadIdx.x == 0) (void)xb_add(&bar[XB_XCNT(b.x)], 1u);
    return b;
}
__device__ __forceinline__ void xcd_barrier_complete(unsigned* bar, unsigned x, unsigned& nloc, unsigned& nx) {
    const unsigned G = gridDim.x * gridDim.y * gridDim.z;
    unsigned sum, cnt, mine, sp = 0u;
    for (;;) {
        sum = 0u; cnt = 0u; mine = 0u;
#pragma unroll
        for (unsigned j = 0; j < 16; ++j) { const unsigned c = xb_ld(&bar[XB_XCNT(j)]); sum += c; cnt += (c > 0u) ? 1u : 0u; mine = (j == x) ? c : mine; }
        if (sum == G) break;
        __builtin_amdgcn_s_sleep(1);
        if ((++sp & 255u) == 0u) { if (xb_ld(&bar[XB_TMO])) break; if (sp > XB_SPIN_CAP) { atomicAdd(&bar[XB_TMO], 1u); break; } }
    }
    nloc = mine > 0u ? mine : 1u; nx = cnt > 0u ? cnt : 1u;
}

__device__ __forceinline__ void xcd_barrier(const XcdBarrier& b) {
    asm volatile("s_waitcnt vmcnt(0)" ::: "memory");
    __syncthreads();
    if (threadIdx.x == 0) {
        unsigned* bar = b.bar;
        __builtin_amdgcn_s_waitcnt(0);
        unsigned nloc = b.st[0], nx = b.st[1];
        if (nloc == 0u) { xcd_barrier_complete(bar, b.x, nloc, nx); b.st[0] = nloc; b.st[1] = nx; }
        const unsigned old = xb_add(&bar[XB_XSUB(b.x)], 1u);
        const unsigned gen = old / nloc;
        if (old + 1u == (gen + 1u) * nloc) {
            __builtin_amdgcn_fence(__ATOMIC_RELEASE, "agent");
            asm volatile("s_waitcnt vmcnt(0)" ::: "memory");
            const unsigned og = xb_add(&bar[XB_TOP], 1u);
            const unsigned tg = og / nx;
            if (og + 1u == (tg + 1u) * nx) xb_add(&bar[XB_TOPGEN], 1u);
            else XB_SPIN(xb_ld(&bar[XB_TOPGEN]) == tg, bar);
            __builtin_amdgcn_fence(__ATOMIC_ACQUIRE, "agent");
            xb_add(&bar[XB_XGEN(b.x)], 1u);
            asm volatile("s_waitcnt vmcnt(0)" ::: "memory");
        } else {
            XB_SPIN(xb_ld(&bar[XB_XGEN(b.x)]) == gen, bar);
            __builtin_amdgcn_fence(__ATOMIC_ACQUIRE, "agent");
            asm volatile("s_waitcnt vmcnt(0)" ::: "memory");
        }
    }
    __syncthreads();
}
struct Frame {
    LAS unsigned char* lds;
    volatile LAS unsigned* MISC;
    gu32* ctl;
    int tid, lane, wave, bid, G, vcu;
    const float *x, *norm_mix, *w_in, *w_pool, *pool_scale, *w_out, *norm_mlp, *w_up, *w_down, *norm_final;
    float* out;
    unsigned char* ws;
    bf16 *WinT, *WoutT, *WupT, *WdnT, *WpT;
    bf16 *Q, *K, *V, *U, *AP, *H, *XN;
    float *KM, *SSQ1, *SSQ2;
};
template <class Epi>
__device__ __forceinline__ void golden_gemm(Frame& F, const bf16* A, const float* B, const float* kscale, int Mr, int N, int K, const Epi& E) {
    LAS float* As = (LAS float*)F.lds;
    LAS float* Bs = (LAS float*)(F.lds + 16 * 68 * 4);
    const int tid = F.tid, tx = tid & 31, ty = tid >> 5;
    const int tilesN = N / 128, ntiles = (Mr / 64) * tilesN;
    for (int t = F.bid; t < ntiles; t += F.G) {
        const int m0 = (t / tilesN) * 64, n0 = (t % tilesN) * 128;
        float acc[4][4];
#pragma unroll
        for (int i = 0; i < 4; ++i)
#pragma unroll
            for (int j = 0; j < 4; ++j) acc[i][j] = 0.f;
        for (int k0 = 0; k0 < K; k0 += 16) {
            { const int r = tid >> 3, kk = (tid & 7) * 2; const unsigned v = *(const unsigned*)(A + (size_t)(m0 + r) * K + k0 + kk);
              As[kk * 68 + r] = bf2f(v & 0xffffu); As[(kk + 1) * 68 + r] = bf2f(v >> 16); }
            { const int kk = tid >> 5, n = (tid & 31) * 4; f32x4 v = *(const f32x4*)(B + (size_t)(k0 + kk) * N + n0 + n); if (kscale) v = v * kscale[k0 + kk];
              *(LAS f32x4*)(Bs + kk * 132 + n) = v; }
            __syncthreads();
#pragma unroll
            for (int kk = 0; kk < 16; ++kk) {
                const f32x4 a = *(const LAS f32x4*)(As + kk * 68 + ty * 4), b = *(const LAS f32x4*)(Bs + kk * 132 + tx * 4);
#pragma unroll
                for (int i = 0; i < 4; ++i)
#pragma unroll
                    for (int j = 0; j < 4; ++j) acc[i][j] = fmaf(a[i], b[j], acc[i][j]);
            }
            __syncthreads();
        }
#pragma unroll
        for (int i = 0; i < 4; ++i) E(m0 + ty * 4 + i, n0 + tx * 4, (f32x4){acc[i][0], acc[i][1], acc[i][2], acc[i][3]});
    }
}

struct GEpiInproj {
    bf16 *Q, *K, *V, *U;
    __device__ __forceinline__ void operator()(int m, int n, f32x4 v) const {
        const int t = n >> 9, c = n & 511; bf16* base = t == 0 ? Q : t == 1 ? K : t == 2 ? V : U;
        if (t == 0) v = v * C2;
        v2u w; w.x = pk2(v[0], v[1]); w.y = pk2(v[2], v[3]); *(v2u*)(base + (size_t)m * 512 + c) = w;
    }
};
struct GEpiOut {
    const float* x; float* out; bf16* XN; float* SSQ;
    __device__ __forceinline__ void operator()(int m, int n, f32x4 v) const {
        const f32x4 b = *(const f32x4*)(x + (size_t)m * D + n); const f32x4 r = b + v; *(f32x4*)(out + (size_t)m * D + n) = r;
        v2u w; w.x = pk2(r[0], r[1]); w.y = pk2(r[2], r[3]); *(v2u*)(XN + (size_t)m * D + n) = w;
        atomicAdd(SSQ + (size_t)m * 4 + (n >> 8), r[0] * r[0] + r[1] * r[1] + r[2] * r[2] + r[3] * r[3]);
    }
};
struct GEpiUp {
    bf16* H; const float* SSQ;
    __device__ __forceinline__ void operator()(int m, int n, f32x4 v) const {
        const f32x4 s = *(const f32x4*)(SSQ + (size_t)m * 4); const float rstd = rsqrtf(((s[0] + s[1]) + (s[2] + s[3])) * (1.f / D) + EPS);
        const float a0 = fmaxf(v[0] * rstd, 0.f), a1 = fmaxf(v[1] * rstd, 0.f), a2 = fmaxf(v[2] * rstd, 0.f), a3 = fmaxf(v[3] * rstd, 0.f);
        const f32x4 r = (f32x4){a0 * a0, a1 * a1, a2 * a2, a3 * a3};
        v2u w; w.x = pk2(r[0], r[1]); w.y = pk2(r[2], r[3]); *(v2u*)(H + (size_t)m * FF + n) = w;
    }
};
struct GEpiDown {
    float* out; float* SSQ;
    __device__ __forceinline__ void operator()(int m, int n, f32x4 v) const {
        const f32x4 b = *(const f32x4*)(out + (size_t)m * D + n); const f32x4 r = b + v; *(f32x4*)(out + (size_t)m * D + n) = r;
        atomicAdd(SSQ + (size_t)m * 4 + (n >> 8), r[0] * r[0] + r[1] * r[1] + r[2] * r[2] + r[3] * r[3]);
    }
};

__device__ __forceinline__ void rms_rows_to_bf16(Frame& F, const float* x, const float* g, bf16* o) {
    const int gw = F.bid * NWAVES + F.wave, NGW = F.G * NWAVES;
    for (int m = gw; m < M; m += NGW) {
        const f32x4* xr = (const f32x4*)(x + (size_t)m * D) + F.lane; const f32x4* gr = (const f32x4*)g + F.lane;
        f32x4 v[4]; float s = 0.f;
#pragma unroll
        for (int j = 0; j < 4; ++j) { v[j] = xr[64 * j]; s += (v[j].x * v[j].x + v[j].y * v[j].y) + (v[j].z * v[j].z + v[j].w * v[j].w); }
        const float rstd = rsqrtf(wave_sum(s) * (1.f / D) + EPS);
        unsigned long long* o8 = (unsigned long long*)(o + (size_t)m * D) + F.lane;
#pragma unroll
        for (int j = 0; j < 4; ++j) { const f32x4 gg = gr[64 * j]; const f32x4 y = v[j] * rstd * gg;
            o8[64 * j] = (unsigned long long)pk2(y.x, y.y) | ((unsigned long long)pk2(y.z, y.w) << 32); }
    }
}
__device__ __forceinline__ void final_norm_rows(Frame& F, float* out, const float* SSQ, const float* g) {
    const int gw = F.bid * NWAVES + F.wave, NGW = F.G * NWAVES;
    for (int m = gw; m < M; m += NGW) {
        const f32x4 s = *(const f32x4*)(SSQ + (size_t)m * 4); const float rstd = rsqrtf(((s[0] + s[1]) + (s[2] + s[3])) * (1.f / D) + EPS);
        f32x4* xr = (f32x4*)(out + (size_t)m * D) + F.lane; const f32x4* gr = (const f32x4*)g + F.lane;
#pragma unroll
        for (int j = 0; j < 4; ++j) { const f32x4 v = xr[64 * j]; xr[64 * j] = v * rstd * gr[64 * j]; }
    }
}
__device__ __forceinline__ void golden_kmean(Frame& F) {
    const int gt = F.bid * (NWAVES * 64) + F.tid, NT = F.G * NWAVES * 64;
    for (int i = gt; i < 64 * 512; i += NT) { const int p = i >> 9, c = i & 511; float s = 0.f;
        for (int r = 0; r < 256; ++r) s += bf2f(F.K[(size_t)(p * 256 + r) * 512 + c]);
        F.KM[(size_t)p * 1024 + c] = s; F.KM[(size_t)p * 1024 + 512 + c] = 0.f; }
}

__device__ __forceinline__ void golden_attention(Frame& F) {
    LAS float* wq = (LAS float*)(F.lds) + F.wave * 1088;
    LAS float* wp = wq + 64;
    const int gw = F.bid * NWAVES + F.wave, NGW = F.G * NWAVES, lane = F.lane;
    for (int it = gw; it < M * NH; it += NGW) {
        const int m = it >> 3, h = it & 7, b = m / SEQ, t = m % SEQ, qb = t / MB;
        const float slope2 = exp2f(-(float)(h + 1)) * LOG2E;
        wq[lane] = bf2f(F.Q[(size_t)m * 512 + h * 64 + lane]);
        __builtin_amdgcn_s_waitcnt(0xC07F); __builtin_amdgcn_wave_barrier();
        float myg = -INFINITY;
        if (lane < 16 && lane < qb) { const float* k0 = F.KM + (size_t)(b * NBLK + lane) * 1024 + h * 64; float s = 0.f;
            for (int d = 0; d < 64; ++d) s = fmaf(wq[d], (k0[d] + k0[512 + d]) * (1.f / 256.f), s);
            myg = s; }
        float g[16];
#pragma unroll
        for (int n = 0; n < 16; ++n) g[n] = __shfl(myg, n);
        unsigned mask = 0u;
#pragma unroll
        for (int k = 0; k < 3; ++k) { if (k < qb) { float best = -INFINITY; int bi = 0; bool found = false;
#pragma unroll
                for (int n = 0; n < 16; ++n) { const bool ok = (n < qb) && !((mask >> n) & 1u) && (!found || g[n] > best); if (ok) { best = g[n]; bi = n; found = true; } }
                mask |= 1u << bi; } }
        mask |= 1u << qb;
        mask = (unsigned)__builtin_amdgcn_readfirstlane((int)mask);
        float mx = -INFINITY; int nblk = 0;
        for (unsigned mm = mask; mm; mm &= mm - 1u) { const int n = __builtin_ctz(mm);
            for (int j = 0; j < 4; ++j) { const int s = n * MB + j * 64 + lane; float sc = -INFINITY;
                if (s <= t) { const bf16* kr = F.K + (size_t)(b * SEQ + s) * 512 + h * 64; float a = 0.f;
                    for (int d = 0; d < 64; d += 2) { const unsigned kk = *(const unsigned*)(kr + d); a = fmaf(wq[d], bf2f(kk & 0xffffu), a); a = fmaf(wq[d + 1], bf2f(kk >> 16), a); }
                    sc = a - slope2 * (float)(t - s); }
                wp[nblk * 256 + j * 64 + lane] = sc; mx = fmaxf(mx, sc); }
            ++nblk; }
        mx = wave_max(mx);
        float l = 0.f;
        for (int i = lane; i < nblk * 256; i += 64) { const float p = exp2f(wp[i] - mx); wp[i] = p; l += p; }
        l = wave_sum(l);
        __builtin_amdgcn_s_waitcnt(0xC07F); __builtin_amdgcn_wave_barrier();
        float acc = 0.f; int bi = 0;
        for (unsigned mm = mask; mm; mm &= mm - 1u) { const int n = __builtin_ctz(mm); const bf16* vr = F.V + (size_t)(b * SEQ + n * MB) * 512 + h * 64 + lane;
            for (int j = 0; j < 256; ++j) acc = fmaf(wp[bi * 256 + j], bf2f(vr[(size_t)j * 512]), acc);
            ++bi; }
        F.AP[(size_t)m * D + h * 64 + lane] = (bf16)f2bf(acc / l);
        __builtin_amdgcn_s_waitcnt(0xC07F); __builtin_amdgcn_wave_barrier();
    }
}
__device__ __forceinline__ void golden_pool(Frame& F) {
    LAS float* mx = (LAS float*)(F.lds) + F.wave * 128;
    const int gw = F.bid * NWAVES + F.wave, NGW = F.G * NWAVES, lane = F.lane;
    for (int it = gw; it < M * NG; it += NGW) {
        const int m = it >> 2, g = it & 3, t = m % SEQ, w = 2 << g, cnt = (t + 1 < w) ? t + 1 : w;
#pragma unroll
        for (int cc = 0; cc < 2; ++cc) { const int c = lane + 64 * cc; float s = 0.f;
            for (int j = 0; j < cnt; ++j) s += bf2f(F.U[(size_t)(m - j) * 512 + g * 128 + c]);
            mx[c] = s / (float)cnt - bf2f(F.U[(size_t)m * 512 + g * 128 + c]); }
        __builtin_amdgcn_s_waitcnt(0xC07F); __builtin_amdgcn_wave_barrier();
#pragma unroll
        for (int cc = 0; cc < 2; ++cc) { const int d = lane + 64 * cc; float a = 0.f; const float* wpp = F.w_pool + (size_t)g * PG * PG + d;
            for (int c = 0; c < PG; ++c) a = fmaf(mx[c], wpp[(size_t)c * PG], a);
            F.AP[(size_t)m * D + 512 + g * 128 + d] = (bf16)f2bf(a * F.pool_scale[g * 128 + d]); }
        __builtin_amdgcn_s_waitcnt(0xC07F); __builtin_amdgcn_wave_barrier();
    }
}

__device__ __forceinline__ void p0_transpose_item(const float* W, int K, int N, bf16* WT, int row_off, LAS float* scr, int item, int lane, const float* kscale, const float* nscale) {
    const int nblk = N / 32, kb = item / nblk, nb = item % nblk, k0 = 64 * kb, n0 = 32 * nb;
    const float ns = nscale ? nscale[n0 + (lane & 31)] : 1.f;
#pragma unroll 8
    for (int i = 0; i < 32; ++i) { const int kk = 2 * i + (lane >> 5); const float ks = kscale ? kscale[k0 + kk] : 1.f; scr[kk * 33 + (lane & 31)] = W[(size_t)(k0 + kk) * N + n0 + (lane & 31)] * ks * ns; }
    LDS_WAIT(); asm volatile("" ::: "memory");
    const int c = lane & 7;
#pragma unroll
    for (int j = 0; j < 4; ++j) { const int n = (lane >> 3) + 8 * j; const LAS float* s = scr + (8 * c) * 33 + n;
        v4u o; o.x = pk2(s[0 * 33], s[1 * 33]); o.y = pk2(s[2 * 33], s[3 * 33]); o.z = pk2(s[4 * 33], s[5 * 33]); o.w = pk2(s[6 * 33], s[7 * 33]);
        *(GAS v4u*)(WT + (size_t)(row_off + n0 + n) * K + k0 + 8 * c) = o; }
    LDS_WAIT(); asm volatile("" ::: "memory");
}
__device__ __forceinline__ void p0_prologue(Frame& F) {
    LAS float* scr = (LAS float*)(F.lds + RING_OFF + F.wave * 16384);
    const int gw = F.vcu * NWAVES + F.wave, NGW = F.G * NWAVES;
    constexpr int I_IN = (D / 64) * (INW / 32), I_OUT = (D / 64) * (D / 32), I_UP = (D / 64) * (FF / 32), I_DN = (FF / 64) * (D / 32), I_P = (PG / 64) * (PG / 32);
    constexpr int NITEMS = I_IN + I_OUT + I_UP + I_DN + NG * I_P;
    for (int it = gw; it < NITEMS; it += NGW) {
        int r = it;
        if (r < I_IN) { p0_transpose_item(F.w_in, D, INW, F.WinT, 0, scr, r, F.lane, nullptr, nullptr); continue; } r -= I_IN;
        if (r < I_OUT) { p0_transpose_item(F.w_out, D, D, F.WoutT, 0, scr, r, F.lane, nullptr, nullptr); continue; } r -= I_OUT;
        if (r < I_UP) { p0_transpose_item(F.w_up, D, FF, F.WupT, 0, scr, r, F.lane, F.norm_mlp, nullptr); continue; } r -= I_UP;
        if (r < I_DN) { p0_transpose_item(F.w_down, FF, D, F.WdnT, 0, scr, r, F.lane, nullptr, nullptr); continue; } r -= I_DN;
        { const int g = r / I_P; p0_transpose_item(F.w_pool + (size_t)g * PG * PG, PG, PG, F.WpT, g * PG, scr, r % I_P, F.lane, nullptr, F.pool_scale + g * PG); }
    }
    rms_rows_to_bf16(F, F.x, F.norm_mix, F.XN);
}
__device__ __forceinline__ void pool_phase(Frame& F) {
    typedef short bf16x8_t __attribute__((ext_vector_type(8)));
    const int lane = F.lane, fr = lane & 15, fq = lane >> 4, g = F.wave & 3, rh = F.wave >> 2, w = 2 << g;
    for (int blk = F.vcu; blk < M / 64; blk += F.G) {
        const int mrow0 = blk * 64 + rh * 32;
        bf16x8_t A[2][4];
#pragma unroll
        for (int mt = 0; mt < 2; ++mt) { const int m = mrow0 + 16 * mt + fr, t = m & (SEQ - 1), cnt = (t + 1 < w) ? t + 1 : w; const float rc = 1.0f / (float)cnt;
#pragma unroll
            for (int ks = 0; ks < 4; ++ks) { const bf16* up = F.U + (size_t)m * 512 + g * 128 + 32 * ks + 8 * fq;
                float s0 = 0.f, s1 = 0.f, s2 = 0.f, s3 = 0.f, s4 = 0.f, s5 = 0.f, s6 = 0.f, s7 = 0.f;
                for (int j = 0; j < w; ++j) if (j < cnt) { const v4u x = *(const v4u*)(up - (size_t)j * 512);
                    s0 += bf2f(x.x & 0xffffu); s1 += bf2f(x.x >> 16); s2 += bf2f(x.y & 0xffffu); s3 += bf2f(x.y >> 16); s4 += bf2f(x.z & 0xffffu); s5 += bf2f(x.z >> 16); s6 += bf2f(x.w & 0xffffu); s7 += bf2f(x.w >> 16); }
                const v4u x = *(const v4u*)up; v4u o;
                o.x = pk2(s0 * rc - bf2f(x.x & 0xffffu), s1 * rc - bf2f(x.x >> 16)); o.y = pk2(s2 * rc - bf2f(x.y & 0xffffu), s3 * rc - bf2f(x.y >> 16));
                o.z = pk2(s4 * rc - bf2f(x.z & 0xffffu), s5 * rc - bf2f(x.z >> 16)); o.w = pk2(s6 * rc - bf2f(x.w & 0xffffu), s7 * rc - bf2f(x.w >> 16));
                A[mt][ks] = __builtin_bit_cast(bf16x8_t, o); } }
        f32x4 acc[2][8];
#pragma unroll
        for (int mt = 0; mt < 2; ++mt)
#pragma unroll
            for (int nt = 0; nt < 8; ++nt) acc[mt][nt] = (f32x4){0.f, 0.f, 0.f, 0.f};
#pragma unroll
        for (int nt = 0; nt < 8; ++nt) { bf16x8_t B[4];
#pragma unroll
            for (int ks = 0; ks < 4; ++ks) B[ks] = *(const bf16x8_t*)(F.WpT + (size_t)(g * 128 + 16 * nt + fr) * 128 + 32 * ks + 8 * fq);
#pragma unroll
            for (int mt = 0; mt < 2; ++mt)
#pragma unroll
                for (int ks = 0; ks < 4; ++ks) acc[mt][nt] = __builtin_amdgcn_mfma_f32_16x16x32_bf16(B[ks], A[mt][ks], acc[mt][nt], 0, 0, 0); }
#pragma unroll
        for (int mt = 0; mt < 2; ++mt) { bf16* op = F.AP + (size_t)(mrow0 + 16 * mt + fr) * D + 512 + g * 128 + 4 * fq;
#pragma unroll
            for (int nt = 0; nt < 8; ++nt) { v2u o; o.x = pk2(acc[mt][nt][0], acc[mt][nt][1]); o.y = pk2(acc[mt][nt][2], acc[mt][nt][3]); *(v2u*)(op + 16 * nt) = o; } }
    }
}
constexpr int N_PHASES = 8;
constexpr int N_LAUNCHES = MK_N_LAUNCHES;
struct Args { const float* in[10]; float* out; unsigned char* ws; int ph_lo, ph_hi, li, pad; };
__global__ void __launch_bounds__(NWAVES * 64, 2) skel_fwd(Args args) {
    extern __shared__ __attribute__((aligned(16))) unsigned char lds[];
    Frame F;
    F.lds = (LAS unsigned char*)lds;
    F.MISC = (volatile LAS unsigned*)(F.lds + MISC_OFF);
    F.tid = threadIdx.x; F.lane = F.tid & 63; F.wave = __builtin_amdgcn_readfirstlane(F.tid >> 6); F.bid = blockIdx.x; F.G = gridDim.x;
    { const int bx = blockIdx.x; F.vcu = (F.G % 8 == 0) ? (bx % 8) * (F.G / 8) + bx / 8 : bx; }
    F.x = args.in[0]; F.norm_mix = args.in[1]; F.w_in = args.in[2]; F.w_pool = args.in[3]; F.pool_scale = args.in[4]; F.w_out = args.in[5];
    F.norm_mlp = args.in[6]; F.w_up = args.in[7]; F.w_down = args.in[8]; F.norm_final = args.in[9];
    F.out = args.out; F.ws = args.ws;
    unsigned char* ws = args.ws;
    F.ctl = (gu32*)(ws + WS_CTL);
    F.WinT = (bf16*)(ws + WS_WIN); F.WoutT = (bf16*)(ws + WS_WOUT); F.WupT = (bf16*)(ws + WS_WUP); F.WdnT = (bf16*)(ws + WS_WDN); F.WpT = (bf16*)(ws + WS_WP);
    F.Q = (bf16*)(ws + WS_Q); F.K = (bf16*)(ws + WS_K); F.V = (bf16*)(ws + WS_V); F.U = (bf16*)(ws + WS_U); F.AP = (bf16*)(ws + WS_AP); F.H = (bf16*)(ws + WS_H); F.XN = (bf16*)(ws + WS_XN);
    F.KM = (float*)(ws + WS_KM); F.SSQ1 = (float*)(ws + WS_CTL + CTL_SSQ1); F.SSQ2 = (float*)(ws + WS_CTL + CTL_SSQ2);
    for (int u = F.tid; u < (LDS_BYTES - LDSCTL_OFF) / 4; u += NWAVES * 64) ((LAS unsigned*)(F.lds + LDSCTL_OFF))[u] = 0u;
    __syncthreads();
    XcdBarrier bar; bar.bar = (unsigned*)(F.ctl + CW_BAR); bar.x = 0; bar.st = nullptr;
    if (N_LAUNCHES == 1) bar = xcd_barrier_post((unsigned*)(F.ctl + CW_BAR), F.MISC + 8);
#define GRID_BAR(seam) do { if (N_LAUNCHES != 1) { if (F.tid == 0) __hip_atomic_store(F.ctl + CW_TMO, 0xBADBA0u | (unsigned)(seam), RLX_AGENT); } else { xcd_barrier(bar); } } while (0)
    const int lo = args.ph_lo, hi = args.ph_hi;
#define IN(k) (lo <= (k) && (k) < hi)
#define BOTH(k) (IN(k) && IN((k) + 1))

    if (IN(0)) { p0_prologue(F); if (BOTH(0)) GRID_BAR(0); }

    if (IN(1)) {
#if G_P1
        { GEpiInproj E{F.Q, F.K, F.V, F.U}; golden_gemm(F, F.XN, F.w_in, nullptr, M, INW, D, E); }
#else
        { pg8::Gemm g{F.XN, F.WinT, M, INW, D}; pg8::StaticOrder S; S.init(M, INW, F.G, (int)blockIdx.x);
          pg8::EpiInproj E{F.Q, (size_t)(WS_K - WS_Q) / 2, C2, F.KM};
          pg8::gemm_phase<pg8::EpiInproj, pg8::StaticOrder, true, true>(F.lds + RING_OFF, g, S, E); }
#endif
        if (BOTH(1)) GRID_BAR(1);
    }
    if (IN(2)) {
#if G_P1
        golden_kmean(F); if (BOTH(2)) GRID_BAR(2);
#endif
    }
    if (IN(3)) {
#if G_P3
        golden_attention(F); __syncthreads(); golden_pool(F);
#else
        { const attn_body::AttnTensors AT{(const attn_body::bf16*)F.Q, (const attn_body::bf16*)F.K, (const attn_body::bf16*)F.V, (attn_body::bf16*)F.AP, F.KM};
          const attn_body::StaticOrder S((int)F.G, (int)blockIdx.x);
          attn_body::attn_phase<attn_body::StaticOrder>((char*)lds + RING_OFF, AT, S); }
        pool_phase(F);
#endif
        if (BOTH(3)) GRID_BAR(3);
    }
    if (IN(4)) {
#if G_P4
        { GEpiOut E{F.x, F.out, F.XN, F.SSQ1}; golden_gemm(F, F.AP, F.w_out, nullptr, M, D, D, E); }
#else
        { pg8::Gemm g{F.AP, F.WoutT, M, D, D}; pg8::StaticOrder S; S.init(M, D, F.G, (int)blockIdx.x);
          pg8::EpiRes<true> E{F.x, F.out, F.XN, F.SSQ1, D};
          pg8::gemm_phase<pg8::EpiRes<true>, pg8::StaticOrder, false, true>(F.lds + RING_OFF, g, S, E); }
#endif
        if (BOTH(4)) GRID_BAR(4);
    }
    if (IN(5)) {
#if G_P5
        { GEpiUp E{F.H, F.SSQ1}; golden_gemm(F, F.XN, F.w_up, F.norm_mlp, M, FF, D, E); }
#else
        { pg8::Gemm g{F.XN, F.WupT, M, FF, D}; pg8::StaticOrder S; S.init(M, FF, F.G, (int)blockIdx.x);
          pg8::EpiUp E{F.H, FF, F.SSQ1, 1.f / D, EPS};
          pg8::gemm_phase<pg8::EpiUp, pg8::StaticOrder, true, true>(F.lds + RING_OFF, g, S, E); }
#endif
        if (BOTH(5)) GRID_BAR(5);
    }
    if (IN(6)) {
#if G_P6
        { GEpiDown E{F.out, F.SSQ2}; golden_gemm(F, F.H, F.w_down, nullptr, M, D, FF, E); }
#else
        { pg8::Gemm g{F.H, F.WdnT, M, D, FF}; pg8::StaticOrder S; S.init(M, D, F.G, (int)blockIdx.x);
          pg8::EpiRes<false> E{F.out, F.out, nullptr, F.SSQ2, D};
          pg8::gemm_phase<pg8::EpiRes<false>, pg8::StaticOrder, false, true>(F.lds + RING_OFF, g, S, E); }
#endif
        if (BOTH(6)) GRID_BAR(6);
    }
    if (IN(7)) { final_norm_rows(F, F.out, F.SSQ2, F.norm_final); }
#undef IN
#undef BOTH
}

extern "C" void kernel_launch(void* const* d_in, const int* in_sizes, int n_in, void* d_out, int out_size, void* d_ws, size_t ws_size, hipStream_t stream) {
    static int grid = 0;
    if (grid == 0) {
        if (n_in != 10 || in_sizes[0] != M * D || out_size != M * D || ws_size < WS_END) { fprintf(stderr, "kernel_launch: unexpected shapes (n_in %d in0 %d out %d ws %zu)\n", n_in, n_in > 0 ? in_sizes[0] : -1, out_size, ws_size); grid = -1; return; }
        int dev = 0, cus = 0;
        if (hipGetDevice(&dev) != hipSuccess || hipDeviceGetAttribute(&cus, hipDeviceAttributeMultiprocessorCount, dev) != hipSuccess) { grid = -1; return; }
        if (hipFuncSetAttribute((const void*)skel_fwd, hipFuncAttributeMaxDynamicSharedMemorySize, LDS_BYTES) != hipSuccess) { fprintf(stderr, "kernel_launch: hipFuncSetAttribute failed\n"); grid = -1; return; }
        (void)hipGetLastError();
        grid = cus;
    }
    if (grid < 0) return;
    if (hipMemsetAsync((char*)d_ws + WS_CTL, 0, CTL_ZERO_BYTES, stream) != hipSuccess) return;
    Args a{};
    for (int i = 0; i < 10; ++i) a.in[i] = (const float*)d_in[i];
    a.out = (float*)d_out; a.ws = (unsigned char*)d_ws;
    if (N_LAUNCHES == 1) { a.ph_lo = 0; a.ph_hi = N_PHASES; a.li = 0; hipLaunchKernelGGL(skel_fwd, dim3(grid), dim3(NWAVES * 64), LDS_BYTES, stream, a); }
    else for (int ph = 0; ph < N_PHASES; ++ph) {
        if (ph == 2 && !G_P1) continue;
        a.ph_lo = ph; a.ph_hi = ph + 1; a.li = ph;
        hipLaunchKernelGGL(skel_fwd, dim3(grid), dim3(NWAVES * 64), LDS_BYTES, stream, a);
    }
}
```
